# Optimizing an MI355X kernel written in HIP

```python
import jax, jax.numpy as jnp
from jax import lax
import numpy as np

D_MODEL = 1024
BATCH = 2
SEQ = 16384
DEPTH = 1
DEC_BATCH = 16
DEC_SEQ = 4096
PAST_LEN = 128

N_HEADS = 8
Q_RANK = 256
KV_RANK = 128
QK_NOPE = 64
QK_ROPE = 32
V_DIM = 64
ATTN_WIDTH = N_HEADS * V_DIM
ROPE_THETA = 10000.0
Q_BLOCK = 128
F_GROUPS = 4
F_GROUP_DIM = 128
F_WIDTH = F_GROUPS * F_GROUP_DIM
IN_COLS = Q_RANK + KV_RANK + QK_ROPE + F_WIDTH + 2 * D_MODEL
D_FF = 2816
CONV_W = 3
EPS = 1e-6

kernel_name = "hybrid_mla_fnet_convffn_encoder"


def _rms(x, g):
    xf = x.astype(jnp.float32)
    r = lax.rsqrt(jnp.mean(xf * xf, axis=-1, keepdims=True) + EPS)
    return (xf * r).astype(x.dtype) * g


def _rope(x, cos, sin):
    half = x.shape[-1] // 2
    xf = x.astype(jnp.float32)
    x1, x2 = xf[..., :half], xf[..., half:]
    out = jnp.concatenate([x1 * cos - x2 * sin, x2 * cos + x1 * sin], axis=-1)
    return out.astype(x.dtype)


def _mla_attention(q_nope, q_rope, k_nope, k_rope, v):
    B, S, H, _ = q_nope.shape
    nb = S // Q_BLOCK
    scale = (QK_NOPE + QK_ROPE) ** -0.5
    qn = q_nope.reshape(B, nb, Q_BLOCK, H, QK_NOPE).transpose(1, 0, 2, 3, 4)
    qr = q_rope.reshape(B, nb, Q_BLOCK, H, QK_ROPE).transpose(1, 0, 2, 3, 4)

    def one_block(args):
        qn_b, qr_b = args
        s = (jnp.einsum('bqhd,bkhd->bhqk', qn_b, k_nope)
             + jnp.einsum('bqhr,bkr->bhqk', qr_b, k_rope))
        p = jax.nn.softmax(s.astype(jnp.float32) * scale, axis=-1)
        return jnp.einsum('bhqk,bkhd->bqhd', p.astype(v.dtype), v)

    o = lax.map(one_block, (qn, qr))
    return o.transpose(1, 0, 2, 3, 4).reshape(B, S, H * V_DIM)


def _fourier(xf):
    B, S, _ = xf.shape
    g = xf.reshape(B, S, F_GROUPS, F_GROUP_DIM).astype(jnp.float32)
    f = jnp.fft.fft2(g, axes=(1, 3), norm='ortho').real
    return f.reshape(B, S, F_WIDTH).astype(xf.dtype)


def _dwconv3(u, w, b):
    up = jnp.pad(u, ((0, 0), (1, 1), (0, 0)))
    return up[:, :-2] * w[0] + up[:, 1:-1] * w[1] + up[:, 2:] * w[2] + b


def _layer(x, g_mix, w_in, g_q, w_uq, g_kv, w_ukv, w_attn_out, w_fourier_out,
           w_out, g_ffn, w_up, conv_w, conv_b, w_down):
    B, S, _ = x.shape
    h = _rms(x, g_mix)
    proj = h @ w_in
    c_q, c_kv, k_rope, xf, gates = jnp.split(
        proj, [Q_RANK, Q_RANK + KV_RANK, Q_RANK + KV_RANK + QK_ROPE,
               Q_RANK + KV_RANK + QK_ROPE + F_WIDTH], axis=-1)

    q = (_rms(c_q, g_q) @ w_uq).reshape(B, S, N_HEADS, QK_NOPE + QK_ROPE)
    q_nope, q_rope = q[..., :QK_NOPE], q[..., QK_NOPE:]
    kv = (_rms(c_kv, g_kv) @ w_ukv).reshape(B, S, N_HEADS, QK_NOPE + V_DIM)
    k_nope, v = kv[..., :QK_NOPE], kv[..., QK_NOPE:]
    pos = jnp.arange(S, dtype=jnp.float32)
    inv_freq = ROPE_THETA ** (-jnp.arange(0, QK_ROPE, 2, dtype=jnp.float32) / QK_ROPE)
    ang = pos[:, None] * inv_freq[None, :]
    cos, sin = jnp.cos(ang), jnp.sin(ang)
    q_rope = _rope(q_rope, cos[:, None, :], sin[:, None, :])
    k_rope = _rope(k_rope, cos, sin)
    a_branch = _mla_attention(q_nope, q_rope, k_nope, k_rope, v) @ w_attn_out

    f_branch = _fourier(xf) @ w_fourier_out

    g = jax.nn.sigmoid(gates)
    g_a, g_f = g[..., :D_MODEL], g[..., D_MODEL:]
    x = x + (g_a * a_branch + g_f * f_branch) @ w_out

    h2 = _rms(x, g_ffn)
    u = _dwconv3(h2 @ w_up, conv_w, conv_b)
    x = x + (jax.nn.silu(u[..., :D_FF]) * u[..., D_FF:]) @ w_down
    return x


def _trunk(x, g_mix, w_in, g_q, w_uq, g_kv, w_ukv, w_attn_out, w_fourier_out,
           w_out, g_ffn, w_up, conv_w, conv_b, w_down, g_final):
    for l in range(DEPTH):
        x = _layer(x, g_mix[l], w_in[l], g_q[l], w_uq[l], g_kv[l], w_ukv[l],
                   w_attn_out[l], w_fourier_out[l], w_out[l], g_ffn[l], w_up[l],
                   conv_w[l], conv_b[l], w_down[l])
    return _rms(x, g_final)


def setup_inputs(seed: int = 0) -> dict:
    key = jax.random.key(seed)
    ks = jax.random.split(key, 20)
    f32 = jnp.float32

    def w(k, shape, fan_in):
        return jax.random.normal(k, shape, f32) * (fan_in ** -0.5)

    def gain(k, shape):
        return 1.0 + 0.02 * jax.random.normal(k, shape, f32)

    L = DEPTH
    return {
        "x_prompt": jax.random.normal(ks[0], (BATCH, SEQ, D_MODEL), f32),
        "x_sample": jax.random.normal(ks[1], (DEC_BATCH, DEC_SEQ, D_MODEL), f32),
        "g_mix": gain(ks[2], (L, D_MODEL)),
        "w_in": w(ks[3], (L, D_MODEL, IN_COLS), D_MODEL),
        "g_q": gain(ks[4], (L, Q_RANK)),
        "w_uq": w(ks[5], (L, Q_RANK, N_HEADS * (QK_NOPE + QK_ROPE)), Q_RANK),
        "g_kv": gain(ks[6], (L, KV_RANK)),
        "w_ukv": w(ks[7], (L, KV_RANK, N_HEADS * (QK_NOPE + V_DIM)), KV_RANK),
        "w_attn_out": w(ks[8], (L, ATTN_WIDTH, D_MODEL), ATTN_WIDTH),
        "w_fourier_out": w(ks[9], (L, F_WIDTH, D_MODEL), F_WIDTH),
        "w_out": w(ks[10], (L, D_MODEL, D_MODEL), D_MODEL),
        "g_ffn": gain(ks[11], (L, D_MODEL)),
        "w_up": w(ks[12], (L, D_MODEL, 2 * D_FF), D_MODEL),
        "conv_w": w(ks[13], (L, CONV_W, 2 * D_FF), CONV_W),
        "conv_b": 0.02 * jax.random.normal(ks[14], (L, 2 * D_FF), f32),
        "w_down": w(ks[15], (L, D_FF, D_MODEL), D_FF),
        "g_final": gain(ks[16], (D_MODEL,)),
    }


def reference(x_prompt, x_sample, g_mix, w_in, g_q, w_uq, g_kv, w_ukv, w_attn_out,
              w_fourier_out, w_out, g_ffn, w_up, conv_w, conv_b, w_down, g_final):
    y_prompt = _trunk(x_prompt, g_mix, w_in, g_q, w_uq, g_kv, w_ukv, w_attn_out,
                      w_fourier_out, w_out, g_ffn, w_up, conv_w, conv_b, w_down, g_final)
    y_sample = _trunk(x_sample, g_mix, w_in, g_q, w_uq, g_kv, w_ukv, w_attn_out,
                      w_fourier_out, w_out, g_ffn, w_up, conv_w, conv_b, w_down, g_final)
    return (y_prompt, y_sample)
```

```cpp
#include <hip/hip_runtime.h>
#include <hip/hip_cooperative_groups.h>
#include <cstdio>
#include <cstdint>
namespace cg = cooperative_groups;

#define LAS __attribute__((address_space(3)))
#define DI __device__ __forceinline__
typedef unsigned short bf16_t;
typedef short bf16x8 __attribute__((ext_vector_type(8)));
typedef short s16x4 __attribute__((ext_vector_type(4)));
typedef float f32x2 __attribute__((ext_vector_type(2)));
typedef float f32x4 __attribute__((ext_vector_type(4)));
typedef float f32x16 __attribute__((ext_vector_type(16)));
typedef unsigned u32x2 __attribute__((ext_vector_type(2)));
typedef unsigned u32x4 __attribute__((ext_vector_type(4)));
typedef __bf16 bf16x2_t __attribute__((ext_vector_type(2)));

constexpr int T = 98304, TP = 32768, DM = 1024, INC = 2976, DFF = 2816;
constexpr float EPS = 1e-6f;
constexpr float LOG2E = 1.4426950408889634f;
constexpr int NWAVES = 8;
constexpr size_t MiB = 1ull << 20;
constexpr size_t WS_R1 = 0, WS_SSQQ = 512 * 1024, WS_SSQKV = 1 * MiB, WS_SSQ2 = 1 * MiB + 512 * 1024, WS_SSQ3 = 2 * MiB;
constexpr size_t WS_ROPEC = 4 * MiB, WS_ROPES = 5 * MiB, WS_BAR = 3 * MiB, WS_PCNT = 3 * MiB + 65536;
constexpr size_t WS_WIN = 6 * MiB, WS_WGA = 7 * MiB, WS_WGF = 9 * MiB, WS_WUQ = 11 * MiB, WS_WUKV = 11 * MiB + 512 * 1024, WS_WAO = 12 * MiB, WS_WFO = 13 * MiB,
                 WS_WO = 14 * MiB, WS_WXF = 16 * MiB, WS_WUP = 18 * MiB, WS_WD = 29 * MiB, WS_DFT = 35 * MiB;
constexpr size_t WS_XB = 40 * MiB, WS_CQ = 232 * MiB, WS_CKV = 280 * MiB, WS_KR = 304 * MiB, WS_Q = 316 * MiB, WS_KN = 460 * MiB, WS_V = 556 * MiB,
                 WS_F = 652 * MiB, WS_AO = 748 * MiB, WS_MIX = 232 * MiB, WS_TMP = 424 * MiB, WS_ACT = 232 * MiB, WS_END = 844 * MiB;
constexpr size_t OUT_XP = 0, OUT_P2 = 192 * MiB;
constexpr int RING_BYTES = 131072, EX_OFF = 131072, MISC_OFF = 139264, LDS_BYTES = 147456;

DI unsigned cvtpk(float lo, float hi) { f32x2 v = {lo, hi}; bf16x2_t b = __builtin_convertvector(v, bf16x2_t); return __builtin_bit_cast(unsigned, b); }
DI float bflo(unsigned w) { return __uint_as_float(w << 16); }
DI float bfhi(unsigned w) { return __uint_as_float(w & 0xffff0000u); }
DI float wave_sum(float v) {
#pragma unroll
    for (int o = 1; o < 64; o <<= 1) v += __shfl_xor(v, o);
    return v;
}
DI float sigmoidf_(float v) { return __builtin_amdgcn_rcpf(1.0f + __builtin_amdgcn_exp2f(-v * LOG2E)); }
DI float sin_rev(float r) { return __builtin_amdgcn_sinf(r); }
DI float cos_rev(float r) { return __builtin_amdgcn_cosf(r); }
DI int tok_pos(int row) { return row < TP ? (row & 16383) : ((row - TP) & 4095); }

namespace pg8 {
constexpr int BM = 256, BK = 64, HALF = 128, HTB = HALF * BK * 2, NXCD = 8, WGM = 8;
DI int lds_byte(int r, int c) { const int st = (r >> 4) * 2 + (c >> 5), rr = r & 15, cc = c & 31, ob = rr * 64 + cc * 2; return st * 1024 + (ob ^ (((ob >> 9) & 1) << 5)); }
DI void stage_rc(int b, int& R, int& C) { const int st = b / 1024, sb = b % 1024, swz = sb ^ (((sb >> 9) & 1) << 5); R = (st >> 1) * 16 + swz / 64; C = (st & 1) * 32 + (swz % 64) / 2; }
DI int perm32(int rho) { const int n = rho >> 4, i = rho & 15; return 8 * (i >> 2) + 4 * n + (i & 3); }
struct Unit { int pm, pn; };
struct StaticOrder {
    int nM, nN, nwg, G, c;
    DI void init(int nM_, int nN_, int G_, int c_) { nM = nM_; nN = nN_; nwg = nM * nN; G = G_; c = c_; }
    DI bool next(int i, Unit& u) const {
        const long L = (long)i * G + c; if (L >= nwg) return false;
        int wgid = (int)L; { const int q = nwg / NXCD, r = nwg % NXCD, xcd = wgid % NXCD, off = wgid / NXCD; wgid = (xcd < r ? xcd * (q + 1) : r * (q + 1) + (xcd - r) * q) + off; }
        const int nig = WGM * nN, gid = wgid / nig, fm = gid * WGM, gsz = (nM - fm) < WGM ? (nM - fm) : WGM;
        u.pm = fm + ((wgid % nig) % gsz); u.pn = (wgid % nig) / gsz; return true;
    }
};
DI void up_tile(int pm, int& row0, int& lo, int& hi) {
    int S, base, j;
    if (pm < 130) { const int s = pm / 65; j = pm - s * 65; S = 16384; base = s * 16384; }
    else { const int p = pm - 130; const int s = p / 17; j = p - s * 17; S = 4096; base = TP + s * 4096; }
    int a = 254 * j - 1; a = a < 0 ? 0 : a; a = a > S - 256 ? S - 256 : a;
    row0 = base + a; lo = (a == 0) ? 0 : 1; hi = (a + 256 == S) ? 255 : 254;
}
template <int KIND> struct Op {
    const char* base; size_t tstep; unsigned rstep; size_t hs;
    DI const char* tile(int p) const {
        if (KIND == 0) return base + (size_t)p * tstep;
        if (KIND == 1) return base + (size_t)((p >> 6) * 16384 + 2 * (p & 63)) * 2048;
        if (KIND == 2) return base + (size_t)((p >> 4) * 4096 + 2 * (p & 15)) * 2048;
        if (KIND == 3) { int row0, lo, hi; up_tile(p, row0, lo, hi); return base + (size_t)row0 * 2048; }
        return base + ((size_t)(p & 1) * tstep + (size_t)(p >> 1)) * 512;
    }
    DI unsigned rowoff(int R) const {
        if (KIND == 2) return (unsigned)(64 * (R & 63) + (R >> 6)) * 2048u;
        return (unsigned)R * rstep;
    }
};

template <class Epi, class OA, class OB>
DI void gemm_phase(LAS unsigned char* lds, const OA PA, const OB PB, const int K, const StaticOrder& S, const Epi& E) {
    int tid_ = threadIdx.x; asm volatile("" : "+v"(tid_));
    const int tid = tid_, wid = __builtin_amdgcn_readfirstlane(tid >> 6), lane = tid & 63, wr = wid >> 2, wc = wid & 3, fr = lane & 15, fq = lane >> 4;
    int nt_ = K / BK; asm volatile("" : "+s"(nt_)); const int nt = nt_;
    unsigned voffA[2], voffB[2];
#pragma unroll
    for (int i = 0; i < 2; ++i) { int R, C; stage_rc(tid * 16 + i * 8192, R, C); const int Rb = (R & ~31) + perm32(R & 31);
        voffA[i] = PA.rowoff(R) + (unsigned)C * 2u; voffB[i] = PB.rowoff(Rb) + (unsigned)C * 2u; }
    const size_t kstep = (size_t)(BK * 2);
    const size_t hsA = PA.hs, hsB = PB.hs;
    const unsigned ldsw = (unsigned)wid * 1024u;
    const int aoff = lds_byte(wr * 64 + fr, fq * 8), boff = lds_byte(wc * 32 + fr, fq * 8);
#define PG8_SA(b, h) (((b) * 2 + (h)) * HTB)
#define PG8_SB(b, h) ((4 + (b) * 2 + (h)) * HTB)
#define PG8_STAGE(bufoff, gbase, voff) do { _Pragma("unroll") for (int _i = 0; _i < 2; ++_i) \
        __builtin_amdgcn_global_load_lds((const unsigned*)((const char*)(gbase) + (voff)[_i]), (LAS unsigned*)(lds + (bufoff) + ldsw + _i * 8192), 16, 0, 0); } while (0)
#define PG8_LDA(dst, b, h) do { _Pragma("unroll") for (int m = 0; m < 4; ++m) _Pragma("unroll") for (int k = 0; k < 2; ++k) dst[m][k] = *(const LAS bf16x8*)(lds + PG8_SA(b, h) + aoff + m * 2048 + k * 1024); } while (0)
#define PG8_LDB(dst, b, h) do { _Pragma("unroll") for (int n = 0; n < 2; ++n) _Pragma("unroll") for (int k = 0; k < 2; ++k) dst[n][k] = *(const LAS bf16x8*)(lds + PG8_SB(b, h) + boff + n * 2048 + k * 1024); } while (0)
#define PG8_MMA(ai, bj, At, Bt) do { __builtin_amdgcn_s_setprio(1); _Pragma("unroll") for (int m = 0; m < 4; ++m) _Pragma("unroll") for (int n = 0; n < 2; ++n) _Pragma("unroll") for (int k = 0; k < 2; ++k) \
        acc[ai][bj][m][n] = __builtin_amdgcn_mfma_f32_16x16x32_bf16(Bt[n][k], At[m][k], acc[ai][bj][m][n], 0, 0, 0); __builtin_amdgcn_s_setprio(0); } while (0)
#define PG8_WAIT_V(n) asm volatile("s_waitcnt vmcnt(" #n ")" ::: "memory")
#define PG8_WAIT_L(n) asm volatile("s_waitcnt lgkmcnt(" #n ")" ::: "memory")
#define PG8_BAR __builtin_amdgcn_s_barrier()
#define PG8_SCHED __builtin_amdgcn_sched_barrier(0)
    Unit cur, nxt; int ui = 0;
    if (!S.next(0, cur)) return;
    f32x4 acc[2][2][4][2];
#pragma unroll
    for (int a = 0; a < 2; ++a)
#pragma unroll
        for (int b = 0; b < 2; ++b)
#pragma unroll
            for (int m = 0; m < 4; ++m)
#pragma unroll
                for (int n = 0; n < 2; ++n) acc[a][b][m][n] = (f32x4){0.f, 0.f, 0.f, 0.f};
    bf16x8 At[4][2], B0[2][2], B1[2][2];
    const char* cA = PA.tile(cur.pm); const char* cB = PB.tile(cur.pn);
    asm volatile("" : "+s"(cA), "+s"(cB));
    PG8_STAGE(PG8_SB(0, 0), cB, voffB); PG8_STAGE(PG8_SB(0, 1), cB + hsB, voffB); PG8_STAGE(PG8_SA(0, 0), cA, voffA); PG8_STAGE(PG8_SA(0, 1), cA + hsA, voffA);
    if (wr == 1) PG8_BAR;
    PG8_WAIT_V(2); PG8_BAR;
    PG8_STAGE(PG8_SB(1, 0), cB + kstep, voffB); PG8_STAGE(PG8_SA(1, 0), cA + kstep, voffA); PG8_STAGE(PG8_SB(1, 1), cB + hsB + kstep, voffB);
    PG8_WAIT_V(6); PG8_BAR;
    for (;;) {
        const bool has_next = S.next(ui + 1, nxt);
        const char* nA = has_next ? PA.tile(nxt.pm) : cA; const char* nB = has_next ? PB.tile(nxt.pn) : cB;
        asm volatile("" : "+s"(nA), "+s"(nB));
        for (int t = 0; t < nt; t += 2) {
            const bool last = (t == nt - 2);
            const char* a1 = cA + (size_t)(t + 1) * kstep;
            const char* a2 = last ? nA : cA + (size_t)(t + 2) * kstep; const char* b2 = last ? nB : cB + (size_t)(t + 2) * kstep;
            const char* a3 = a2 + kstep; const char* b3 = b2 + kstep;
            PG8_LDB(B0, 0, 0); PG8_LDB(B1, 0, 1); PG8_SCHED; PG8_LDA(At, 0, 0); PG8_STAGE(PG8_SA(1, 1), a1 + hsA, voffA);
            PG8_WAIT_V(8); PG8_WAIT_L(0); PG8_BAR; PG8_MMA(0, 0, At, B0); PG8_MMA(0, 1, At, B1); PG8_BAR; PG8_SCHED;
            PG8_LDA(At, 0, 1); PG8_STAGE(PG8_SB(0, 0), b2, voffB); PG8_STAGE(PG8_SB(0, 1), b2 + hsB, voffB); PG8_STAGE(PG8_SA(0, 0), a2, voffA);
            PG8_WAIT_V(8); PG8_WAIT_L(0); PG8_BAR; PG8_MMA(1, 0, At, B0); PG8_MMA(1, 1, At, B1); PG8_BAR; PG8_SCHED;
            PG8_LDB(B0, 1, 0); PG8_LDB(B1, 1, 1); PG8_SCHED; PG8_LDA(At, 1, 0); PG8_STAGE(PG8_SA(0, 1), a2 + hsA, voffA);
            PG8_WAIT_V(8); PG8_WAIT_L(0); PG8_BAR; PG8_MMA(0, 0, At, B0); PG8_MMA(0, 1, At, B1); PG8_BAR; PG8_SCHED;
            PG8_LDA(At, 1, 1); PG8_STAGE(PG8_SB(1, 0), b3, voffB); PG8_STAGE(PG8_SB(1, 1), b3 + hsB, voffB); PG8_STAGE(PG8_SA(1, 0), a3, voffA);
            PG8_WAIT_V(8); PG8_WAIT_L(0); PG8_BAR; PG8_MMA(1, 0, At, B0); PG8_MMA(1, 1, At, B1); PG8_BAR; PG8_SCHED;
        }
        if (wr == 0) PG8_BAR;
        E(acc, cur, wr, wc, fr, fq);
        if (!has_next) break;
#pragma unroll
        for (int a = 0; a < 2; ++a)
#pragma unroll
            for (int b = 0; b < 2; ++b)
#pragma unroll
                for (int m = 0; m < 4; ++m)
#pragma unroll
                    for (int n = 0; n < 2; ++n) acc[a][b][m][n] = (f32x4){0.f, 0.f, 0.f, 0.f};
        cur = nxt; cA = nA; cB = nB; ++ui;
        if (wr == 1) PG8_BAR;
    }
    PG8_WAIT_V(0);
    PG8_BAR;
#undef PG8_SA
#undef PG8_SB
#undef PG8_STAGE
#undef PG8_LDA
#undef PG8_LDB
#undef PG8_MMA
#undef PG8_WAIT_V
#undef PG8_WAIT_L
#undef PG8_BAR
#undef PG8_SCHED
}

typedef f32x4 Acc[2][2][4][2];
#define EPI_LOOP_AI_M _Pragma("unroll") for (int ai = 0; ai < 2; ++ai) _Pragma("unroll") for (int m = 0; m < 4; ++m)
DI u32x4 pack8(f32x4 v0, f32x4 v1) { u32x4 w; w.x = cvtpk(v0[0], v0[1]); w.y = cvtpk(v0[2], v0[3]); w.z = cvtpk(v1[0], v1[1]); w.w = cvtpk(v1[2], v1[3]); return w; }
DI float dot4(f32x4 v) { return (v[0] * v[0] + v[1] * v[1]) + (v[2] * v[2] + v[3] * v[3]); }
DI f32x4 rope4(f32x4 v, const float* rc, const float* rs, int pos, int i0) {
    const f32x2 c = *(const f32x2*)(rc + pos * 16 + i0), s = *(const f32x2*)(rs + pos * 16 + i0);
    f32x4 o; o[0] = v[0] * c[0] - v[1] * s[0]; o[1] = v[1] * c[0] + v[0] * s[0]; o[2] = v[2] * c[1] - v[3] * s[1]; o[3] = v[3] * c[1] + v[2] * s[1]; return o;
}

struct EpiInproj {
    const float* r1; bf16_t* CQ; bf16_t* CKV; bf16_t* KR; float* ssqq; float* ssqkv; const float* rc; const float* rs;
    DI void operator()(Acc& acc, const Unit& u, int wr, int wc, int fr, int fq) const {
        float scv[2][4];
        EPI_LOOP_AI_M scv[ai][m] = r1[u.pm * 256 + ai * 128 + wr * 64 + m * 16 + fr];
        EPI_LOOP_AI_M {
            const int row = u.pm * 256 + ai * 128 + wr * 64 + m * 16 + fr; const float sc = scv[ai][m]; float ss = 0.f;
#pragma unroll
            for (int bj = 0; bj < 2; ++bj) {
                f32x4 v0 = acc[ai][bj][m][0] * sc, v1 = acc[ai][bj][m][1] * sc; const int cl = bj * 128 + wc * 32 + 8 * fq;
                if (u.pn == 0) { ss += dot4(v0) + dot4(v1); *(u32x4*)(CQ + (size_t)row * 256 + cl) = pack8(v0, v1); }
                else if (bj == 0) { ss += dot4(v0) + dot4(v1); *(u32x4*)(CKV + (size_t)row * 128 + cl) = pack8(v0, v1); }
                else if (wc == 0) { const int pos = tok_pos(row); v0 = rope4(v0, rc, rs, pos, 4 * fq); v1 = rope4(v1, rc, rs, pos, 4 * fq + 2);
                    *(u32x4*)(KR + (size_t)row * 32 + 8 * fq) = pack8(v0, v1); }
            }
            ss += __shfl_xor(ss, 16); ss += __shfl_xor(ss, 32);
            if (fq == 0) atomicAdd((u.pn == 0 ? ssqq : ssqkv) + row, ss);
        }
    }
};
struct EpiQup {
    const float* ssqq; bf16_t* Q; const float* rc; const float* rs;
    DI void operator()(Acc& acc, const Unit& u, int wr, int wc, int fr, int fq) const {
        float scv[2][4];
        EPI_LOOP_AI_M scv[ai][m] = ssqq[u.pm * 256 + ai * 128 + wr * 64 + m * 16 + fr];
        EPI_LOOP_AI_M {
            const int row = u.pm * 256 + ai * 128 + wr * 64 + m * 16 + fr; const float sc = __builtin_amdgcn_rsqf(scv[ai][m] * (1.0f / 256.0f) + EPS); const int pos = tok_pos(row);
#pragma unroll
            for (int bj = 0; bj < 2; ++bj) {
                const int c0 = u.pn * 256 + bj * 128 + wc * 32 + 8 * fq; f32x4 v[2];
#pragma unroll
                for (int n = 0; n < 2; ++n) { v[n] = acc[ai][bj][m][n] * sc; const int c4 = c0 + 4 * n, h = c4 / 96, d = c4 - 96 * h;
                    if (d >= 64) v[n] = rope4(v[n], rc, rs, pos, (d - 64) >> 1); }
                *(u32x4*)(Q + (size_t)row * 768 + c0) = pack8(v[0], v[1]);
                asm volatile("" ::: "memory"); __builtin_amdgcn_sched_barrier(0);
            }
        }
    }
};
struct EpiKVup {
    const float* ssqkv; bf16_t* KN; bf16_t* V;
    DI void operator()(Acc& acc, const Unit& u, int wr, int wc, int fr, int fq) const {
        bf16_t* dst = (u.pn < 2 ? KN : V) + (u.pn & 1) * 256;
        float scv[2][4];
        EPI_LOOP_AI_M scv[ai][m] = ssqkv[u.pm * 256 + ai * 128 + wr * 64 + m * 16 + fr];
        EPI_LOOP_AI_M {
            const int row = u.pm * 256 + ai * 128 + wr * 64 + m * 16 + fr; const float sc = __builtin_amdgcn_rsqf(scv[ai][m] * (1.0f / 128.0f) + EPS);
#pragma unroll
            for (int bj = 0; bj < 2; ++bj) *(u32x4*)(dst + (size_t)row * 512 + bj * 128 + wc * 32 + 8 * fq) = pack8(acc[ai][bj][m][0] * sc, acc[ai][bj][m][1] * sc);
        }
    }
};
struct EpiGate {
    const float* r1; bf16_t* DST;
    DI void operator()(Acc& acc, const Unit& u, int wr, int wc, int fr, int fq) const {
        float scv[2][4];
        EPI_LOOP_AI_M scv[ai][m] = r1[u.pm * 256 + ai * 128 + wr * 64 + m * 16 + fr];
        EPI_LOOP_AI_M {
            const int row = u.pm * 256 + ai * 128 + wr * 64 + m * 16 + fr; const float sc = scv[ai][m];
#pragma unroll
            for (int bj = 0; bj < 2; ++bj) { f32x4 v0 = acc[ai][bj][m][0] * sc, v1 = acc[ai][bj][m][1] * sc;
#pragma unroll
                for (int e = 0; e < 4; ++e) { v0[e] = sigmoidf_(v0[e]); v1[e] = sigmoidf_(v1[e]); }
                *(u32x4*)(DST + (size_t)row * 1024 + u.pn * 256 + bj * 128 + wc * 32 + 8 * fq) = pack8(v0, v1); }
        }
    }
};
template <bool FMA> struct EpiMix {
    bf16_t* MIX; const bf16_t* TMPB;
    DI void operator()(Acc& acc, const Unit& u, int wr, int wc, int fr, int fq) const {
#pragma unroll
        for (int ai = 0; ai < 2; ++ai) {
            u32x4 wv[4][2], gv[4][2];
#pragma unroll
            for (int m = 0; m < 4; ++m)
#pragma unroll
                for (int bj = 0; bj < 2; ++bj) { const size_t off = (size_t)(u.pm * 256 + ai * 128 + wr * 64 + m * 16 + fr) * 1024 + u.pn * 256 + bj * 128 + wc * 32 + 8 * fq;
                    wv[m][bj] = *(const u32x4*)(MIX + off); if (FMA) gv[m][bj] = *(const u32x4*)(TMPB + off); }
#pragma unroll
            for (int m = 0; m < 4; ++m)
#pragma unroll
                for (int bj = 0; bj < 2; ++bj) { const size_t off = (size_t)(u.pm * 256 + ai * 128 + wr * 64 + m * 16 + fr) * 1024 + u.pn * 256 + bj * 128 + wc * 32 + 8 * fq;
                    const u32x4 w = wv[m][bj]; const f32x4 a0 = acc[ai][bj][m][0], a1 = acc[ai][bj][m][1]; f32x4 v0, v1;
                    if (FMA) { const u32x4 g = gv[m][bj];
                        v0 = (f32x4){bflo(w.x) + bflo(g.x) * a0[0], bfhi(w.x) + bfhi(g.x) * a0[1], bflo(w.y) + bflo(g.y) * a0[2], bfhi(w.y) + bfhi(g.y) * a0[3]};
                        v1 = (f32x4){bflo(w.z) + bflo(g.z) * a1[0], bfhi(w.z) + bfhi(g.z) * a1[1], bflo(w.w) + bflo(g.w) * a1[2], bfhi(w.w) + bfhi(g.w) * a1[3]};
                    } else {
                        v0 = (f32x4){bflo(w.x) * a0[0], bfhi(w.x) * a0[1], bflo(w.y) * a0[2], bfhi(w.y) * a0[3]};
                        v1 = (f32x4){bflo(w.z) * a1[0], bfhi(w.z) * a1[1], bflo(w.w) * a1[2], bfhi(w.w) * a1[3]};
                    }
                    *(u32x4*)(MIX + off) = pack8(v0, v1); }
        }
    }
};
template <bool WB> struct EpiRes {
    const float* xp; const float* xs; float* out; bf16_t* XB1; float* ssq;
    DI void operator()(Acc& acc, const Unit& u, int wr, int wc, int fr, int fq) const {
#pragma unroll
        for (int ai = 0; ai < 2; ++ai) {
            f32x4 pre[4][2][2];
#pragma unroll
            for (int m = 0; m < 4; ++m) { const int row = u.pm * 256 + ai * 128 + wr * 64 + m * 16 + fr;
                const float* brow = WB ? (row < TP ? xp + (size_t)row * 1024 : xs + (size_t)(row - TP) * 1024) : out + (size_t)row * 1024;
#pragma unroll
                for (int bj = 0; bj < 2; ++bj) { const int c0 = u.pn * 256 + bj * 128 + wc * 32 + 8 * fq; pre[m][bj][0] = *(const f32x4*)(brow + c0); pre[m][bj][1] = *(const f32x4*)(brow + c0 + 4); } }
#pragma unroll
            for (int m = 0; m < 4; ++m) { const int row = u.pm * 256 + ai * 128 + wr * 64 + m * 16 + fr; float ss = 0.f;
#pragma unroll
                for (int bj = 0; bj < 2; ++bj) { const int c0 = u.pn * 256 + bj * 128 + wc * 32 + 8 * fq;
                    const f32x4 v0 = pre[m][bj][0] + acc[ai][bj][m][0], v1 = pre[m][bj][1] + acc[ai][bj][m][1];
                    *(f32x4*)(out + (size_t)row * 1024 + c0) = v0; *(f32x4*)(out + (size_t)row * 1024 + c0 + 4) = v1; ss += dot4(v0) + dot4(v1);
                    if (WB) *(u32x4*)(XB1 + (size_t)row * 1024 + c0) = pack8(v0, v1); }
                ss += __shfl_xor(ss, 16); ss += __shfl_xor(ss, 32);
                if (fq == 0) atomicAdd(ssq + row, ss); }
        }
    }
};
struct EpiFinal {
    float* out; float* ssq; unsigned* cnt; const float* gfin;
    DI void operator()(Acc& acc, const Unit& u, int wr, int wc, int fr, int fq) const {
#pragma unroll
        for (int ai = 0; ai < 2; ++ai) {
            f32x4 pre[4][2][2];
#pragma unroll
            for (int m = 0; m < 4; ++m) { const float* brow = out + (size_t)(u.pm * 256 + ai * 128 + wr * 64 + m * 16 + fr) * 1024;
#pragma unroll
                for (int bj = 0; bj < 2; ++bj) { const int c0 = u.pn * 256 + bj * 128 + wc * 32 + 8 * fq; pre[m][bj][0] = *(const f32x4*)(brow + c0); pre[m][bj][1] = *(const f32x4*)(brow + c0 + 4); } }
#pragma unroll
            for (int m = 0; m < 4; ++m) { const int row = u.pm * 256 + ai * 128 + wr * 64 + m * 16 + fr; float ss = 0.f;
#pragma unroll
                for (int bj = 0; bj < 2; ++bj) { acc[ai][bj][m][0] += pre[m][bj][0]; acc[ai][bj][m][1] += pre[m][bj][1]; ss += dot4(acc[ai][bj][m][0]) + dot4(acc[ai][bj][m][1]); }
                ss += __shfl_xor(ss, 16); ss += __shfl_xor(ss, 32);
                if (fq == 0) atomicAdd(ssq + row, ss); }
        }
        asm volatile("s_waitcnt vmcnt(0)" ::: "memory");
        unsigned* c = cnt + 16 * u.pm;
        if (fr == 0 && fq == 0) __hip_atomic_fetch_add(c, 1u, __ATOMIC_RELAXED, __HIP_MEMORY_SCOPE_AGENT);
        for (unsigned it = 0; it < (1u << 22); ++it) {
            if ((unsigned)__builtin_amdgcn_readfirstlane((int)__hip_atomic_load(c, __ATOMIC_RELAXED, __HIP_MEMORY_SCOPE_AGENT)) >= 32u) break;
            __builtin_amdgcn_s_sleep(2);
        }
        asm volatile("" ::: "memory");
        EPI_LOOP_AI_M {
            const int row = u.pm * 256 + ai * 128 + wr * 64 + m * 16 + fr;
            const float sc = __builtin_amdgcn_rsqf(__hip_atomic_load(ssq + row, __ATOMIC_RELAXED, __HIP_MEMORY_SCOPE_AGENT) * (1.0f / 1024.0f) + EPS);
#pragma unroll
            for (int bj = 0; bj < 2; ++bj) { const int c0 = u.pn * 256 + bj * 128 + wc * 32 + 8 * fq;
                *(f32x4*)(out + (size_t)row * 1024 + c0) = acc[ai][bj][m][0] * sc * *(const f32x4*)(gfin + c0);
                *(f32x4*)(out + (size_t)row * 1024 + c0 + 4) = acc[ai][bj][m][1] * sc * *(const f32x4*)(gfin + c0 + 4); }
        }
    }
};
template <int TYPE> struct EpiF1 {
    const float* r1; bf16_t* XP;
    DI void operator()(Acc& acc, const Unit& u, int wr, int wc, int fr, int fq) const {
        float rr[2][8]; int b, n2b, n10;
        if (TYPE == 0) { b = u.pn >> 6; n2b = 2 * (u.pn & 63); n10 = wc * 32 + 8 * fq; }
        else { b = u.pn >> 4; n2b = 2 * (u.pn & 15) + (wc >> 1); n10 = (wc & 1) * 32 + 8 * fq; }
#pragma unroll
        for (int bj = 0; bj < 2; ++bj)
#pragma unroll
            for (int e = 0; e < 8; ++e) { const int t = (TYPE == 0) ? b * 16384 + 128 * (n10 + e) + n2b + bj : TP + b * 4096 + 64 * (n10 + e) + n2b + 32 * bj; rr[bj][e] = r1[t]; }
        EPI_LOOP_AI_M {
            const int ch = 128 * u.pm + wr * 64 + m * 16 + fr;
#pragma unroll
            for (int bj = 0; bj < 2; ++bj) {
                const size_t addr = (TYPE == 0) ? ((size_t)((ch * 2 + b) * 128 + n2b + bj)) * 256 + ai * 128 + n10
                                                : ((size_t)(((ch * 16 + b) * 32 + n2b) * 2 + bj)) * 128 + ai * 64 + n10;
                f32x4 v0 = acc[ai][bj][m][0], v1 = acc[ai][bj][m][1];
#pragma unroll
                for (int e = 0; e < 4; ++e) { v0[e] *= rr[bj][e]; v1[e] *= rr[bj][4 + e]; }
                *(u32x4*)(XP + addr) = pack8(v0, v1);
            }
        }
    }
};
template <int TYPE> struct EpiF2 {
    bf16_t* P2;
    DI void operator()(Acc& acc, const Unit& u, int wr, int wc, int fr_, int fq) const {
        int fr = fr_; asm volatile("" : "+v"(fr));
#pragma unroll
        for (int m = 0; m < 4; ++m) {
#pragma unroll
            for (int bj = 0; bj < 2; ++bj) {
                int k1, n20, chb; size_t addr;
                if (TYPE == 0) { k1 = wr * 64 + m * 16 + fr; n20 = wc * 32 + 8 * fq; chb = 2 * u.pn + bj; addr = ((size_t)chb * 128 + k1) * 256 + n20; }
                else { k1 = m * 16 + fr; n20 = 32 * wr + 8 * fq; chb = 8 * u.pn + bj * 4 + wc; addr = ((size_t)chb * 32 + (k1 & 31)) * 256 + (k1 >> 5) * 128 + n20; }
#pragma unroll
                for (int n = 0; n < 2; ++n) {
                    float pr[4], pi[4];
#pragma unroll
                    for (int e = 0; e < 4; ++e) { const int n2 = n20 + 4 * n + e;
                        const float rev = (TYPE == 0) ? (float)((n2 * k1) & 16383) * (1.0f / 16384.0f) : (float)((n2 * k1) & 4095) * (1.0f / 4096.0f);
                        const float cs = cos_rev(rev), sn = sin_rev(rev), ar = acc[0][bj][m][n][e], aim = acc[1][bj][m][n][e];
                        pr[e] = ar * cs + aim * sn; pi[e] = aim * cs - ar * sn; }
                    u32x2 w0, w1; w0.x = cvtpk(pr[0], pr[1]); w0.y = cvtpk(pr[2], pr[3]); w1.x = cvtpk(pi[0], pi[1]); w1.y = cvtpk(pi[2], pi[3]);
                    *(u32x2*)(P2 + addr + 4 * n) = w0;
                    *(u32x2*)(P2 + addr + 4 * n + (TYPE == 0 ? 128 : 64)) = w1;
                    asm volatile("" ::: "memory"); __builtin_amdgcn_sched_barrier(0);
                }
            }
        }
    }
};
template <int TYPE> struct EpiF3 {
    bf16_t* Fo;
    DI void operator()(Acc& acc, const Unit& u, int wr, int wc, int fr, int fq) const {
        const int bk = u.pn >> 1, chh = (u.pn & 1) * 256;
#pragma unroll
        for (int m = 0; m < 4; ++m) {
            int tok;
            if (TYPE == 0) { const int b = bk >> 7, k1 = bk & 127, k2 = wr * 64 + m * 16 + fr; tok = b * 16384 + k1 + 128 * k2; }
            else { const int b = bk >> 5, k1 = (bk & 31) + 32 * wr, k2 = m * 16 + fr; tok = TP + b * 4096 + k1 + 64 * k2; }
#pragma unroll
            for (int bj = 0; bj < 2; ++bj) *(u32x4*)(Fo + (size_t)tok * 512 + chh + bj * 128 + wc * 32 + 8 * fq) = pack8(acc[0][bj][m][0], acc[0][bj][m][1]);
        }
    }
};
DI float dpp_up(float prev, float cur) { return __int_as_float(__builtin_amdgcn_update_dpp(__float_as_int(prev), __float_as_int(cur), 0x111, 0xf, 0xf, false)); }
DI float dpp_dn(float next, float cur) { return __int_as_float(__builtin_amdgcn_update_dpp(__float_as_int(next), __float_as_int(cur), 0x101, 0xf, 0xf, false)); }
DI float ror1(float x) { return __int_as_float(__builtin_amdgcn_update_dpp(0, __float_as_int(x), 0x121, 0xf, 0xf, false)); }
DI float ror15(float x) { return __int_as_float(__builtin_amdgcn_update_dpp(0, __float_as_int(x), 0x12F, 0xf, 0xf, false)); }
struct EpiUp {
    const float* ssq2; const float* cw; const float* cb; bf16_t* ACT; LAS float* ex;
    DI void operator()(Acc& acc, const Unit& u, int wr, int wc, int fr, int fq) const {
        int row0, lo, hi; up_tile(u.pm, row0, lo, hi);
        float scv[2][4];
        EPI_LOOP_AI_M scv[ai][m] = ssq2[row0 + ai * 128 + wr * 64 + m * 16 + fr];
        EPI_LOOP_AI_M { const float sc = __builtin_amdgcn_rsqf(scv[ai][m] * (1.0f / 1024.0f) + EPS);
#pragma unroll
            for (int bj = 0; bj < 2; ++bj) { acc[ai][bj][m][0] *= sc; acc[ai][bj][m][1] *= sc; } }
#pragma unroll
        for (int ai = 0; ai < 2; ++ai)
#pragma unroll
            for (int bj = 0; bj < 2; ++bj)
#pragma unroll
                for (int n = 0; n < 2; ++n) { const int col = bj * 128 + wc * 32 + 8 * fq + 4 * n, blk = ai * 2 + wr;
                    if (fr == 0) *(LAS f32x4*)(ex + (blk * 2 + 0) * 256 + col) = acc[ai][bj][0][n];
                    if (fr == 15) *(LAS f32x4*)(ex + (blk * 2 + 1) * 256 + col) = acc[ai][bj][3][n]; }
        asm volatile("s_waitcnt lgkmcnt(0)" ::: "memory"); __builtin_amdgcn_s_barrier(); asm volatile("" ::: "memory");
#pragma unroll
        for (int n = 0; n < 2; ++n) {
            const int cl = wc * 32 + 8 * fq + 4 * n, cgc = u.pn * 128 + cl;
            f32x4 w0[2], w1[2], w2[2], bb[2];
#pragma unroll
            for (int bj = 0; bj < 2; ++bj) { const int c = bj * DFF + cgc; w0[bj] = *(const f32x4*)(cw + c); w1[bj] = *(const f32x4*)(cw + 2 * DFF + c); w2[bj] = *(const f32x4*)(cw + 4 * DFF + c); bb[bj] = *(const f32x4*)(cb + c); }
#pragma unroll
            for (int ai = 0; ai < 2; ++ai) {
                const int blk = ai * 2 + wr; f32x4 eu[2], ed[2];
#pragma unroll
                for (int bj = 0; bj < 2; ++bj) { const int col = bj * 128 + cl;
                    eu[bj] = blk > 0 ? *(const LAS f32x4*)(ex + ((blk - 1) * 2 + 1) * 256 + col) : (f32x4){0.f, 0.f, 0.f, 0.f};
                    ed[bj] = blk < 3 ? *(const LAS f32x4*)(ex + ((blk + 1) * 2 + 0) * 256 + col) : (f32x4){0.f, 0.f, 0.f, 0.f}; }
#pragma unroll
                for (int m = 0; m < 4; ++m) {
                    float cv[2][4];
#pragma unroll
                    for (int bj = 0; bj < 2; ++bj)
#pragma unroll
                        for (int e = 0; e < 4; ++e) { const float cur = acc[ai][bj][m][n][e];
                            const float prev = (m > 0) ? ror1(acc[ai][bj][m > 0 ? m - 1 : 0][n][e]) : eu[bj][e];
                            const float next = (m < 3) ? ror15(acc[ai][bj][m < 3 ? m + 1 : 3][n][e]) : ed[bj][e];
                            const float up = dpp_up(prev, cur), dn = dpp_dn(next, cur);
                            cv[bj][e] = w0[bj][e] * up + w1[bj][e] * cur + w2[bj][e] * dn + bb[bj][e]; }
                    float o[4];
#pragma unroll
                    for (int e = 0; e < 4; ++e) o[e] = cv[0][e] * sigmoidf_(cv[0][e]) * cv[1][e];
                    const int i = ai * 128 + wr * 64 + m * 16 + fr;
                    if (i >= lo && i <= hi) { u32x2 w; w.x = cvtpk(o[0], o[1]); w.y = cvtpk(o[2], o[3]); *(u32x2*)(ACT + (size_t)(row0 + i) * DFF + cgc) = w; }
                }
            }
        }
    }
};
}

namespace att {
constexpr int QBLK = 32, KVBLK = 64;
constexpr int SHM_V = KVBLK * 64 * 2, SHM_K = KVBLK * 256;
constexpr float THR2 = 8.0f;
#define KSWZ(row, colB) ((row) * 256 + ((colB) ^ (((row) & 15) << 4)))
#define SBAR() __builtin_amdgcn_sched_barrier(0)
DI int crow(int r, int hi) { return (r & 3) + 8 * (r >> 2) + 4 * hi; }
DI unsigned cvtpk_a(float lo, float hi) { unsigned r; asm volatile("v_cvt_pk_bf16_f32 %0, %1, %2" : "=v"(r) : "v"(lo), "v"(hi)); return r; }
DI void partialSM(f32x16& p0, f32x16& p1, float& m_reg, float& mn, float& alpha) {
    float pmax = p0[0];
#pragma unroll
    for (int r = 1; r < 16; ++r) pmax = fmaxf(pmax, p0[r]);
#pragma unroll
    for (int r = 0; r < 16; ++r) pmax = fmaxf(pmax, p1[r]);
    { auto rr = __builtin_amdgcn_permlane32_swap(__float_as_uint(pmax), __float_as_uint(pmax), false, false); pmax = fmaxf(__uint_as_float(rr[0]), __uint_as_float(rr[1])); }
    if (__builtin_expect(__all(pmax - m_reg <= THR2), 1)) { mn = m_reg; alpha = 1.f; }
    else { mn = fmaxf(m_reg, pmax); alpha = __builtin_amdgcn_exp2f(m_reg - mn); m_reg = mn; }
    { f32x2 nm = {-mn, -mn}; asm volatile("" : "+v"(nm));
#pragma unroll
      for (int r = 0; r < 8; ++r) { f32x2 a = {p0[2 * r], p0[2 * r + 1]}, b = {p1[2 * r], p1[2 * r + 1]}; a = a + nm; b = b + nm; p0[2 * r] = a[0]; p0[2 * r + 1] = a[1]; p1[2 * r] = b[0]; p1[2 * r + 1] = b[1]; } }
#pragma unroll
    for (int r = 0; r < 16; ++r) p0[r] = __builtin_amdgcn_exp2f(p0[r]);
}
DI void finishSM(f32x16& p0, f32x16& p1, float alpha, float& l_reg, bf16x8& pa0, bf16x8& pa1, bf16x8& pa2, bf16x8& pa3) {
#pragma unroll
    for (int r = 0; r < 16; ++r) p1[r] = __builtin_amdgcn_exp2f(p1[r]);
    typedef float f32x8_ __attribute__((ext_vector_type(8)));
    const f32x16 t16 = p0 + p1;
    const f32x8_ t8 = __builtin_shufflevector(t16, t16, 0, 1, 2, 3, 4, 5, 6, 7) + __builtin_shufflevector(t16, t16, 8, 9, 10, 11, 12, 13, 14, 15);
    const f32x4 t4 = __builtin_shufflevector(t8, t8, 0, 1, 2, 3) + __builtin_shufflevector(t8, t8, 4, 5, 6, 7);
    const f32x2 t2 = __builtin_shufflevector(t4, t4, 0, 1) + __builtin_shufflevector(t4, t4, 2, 3);
    float ps = t2[0] + t2[1];
    { auto rr = __builtin_amdgcn_permlane32_swap(__float_as_uint(ps), __float_as_uint(ps), false, false); ps = __uint_as_float(rr[0]) + __uint_as_float(rr[1]); }
    l_reg = l_reg * alpha + ps;
#define PK4(P, BASE, OUT) do { unsigned a0 = cvtpk_a(P[BASE + 0], P[BASE + 1]), a1 = cvtpk_a(P[BASE + 2], P[BASE + 3]);   \
    unsigned b0 = cvtpk_a(P[BASE + 4], P[BASE + 5]), b1 = cvtpk_a(P[BASE + 6], P[BASE + 7]);                              \
    auto r0 = __builtin_amdgcn_permlane32_swap(a0, b0, false, false); auto r1 = __builtin_amdgcn_permlane32_swap(a1, b1, false, false); \
    u32x4 w = {r0[0], r1[0], r0[1], r1[1]}; OUT = *reinterpret_cast<bf16x8*>(&w); } while (0)
    PK4(p0, 0, pa0); PK4(p0, 8, pa1); PK4(p1, 0, pa2); PK4(p1, 8, pa3);
#undef PK4
}
DI void qkt(f32x16& p0, f32x16& p1, const char* Ks, const bf16x8* qr, int r32, int hi) {
    p0 = f32x16{}; p1 = f32x16{};
#pragma unroll
    for (int d0 = 0; d0 < 6; ++d0) { const int cb = (d0 * 16 + hi * 8) * 2;
        const bf16x8 b0 = *reinterpret_cast<const bf16x8*>(Ks + KSWZ(r32, cb));
        const bf16x8 b1 = *reinterpret_cast<const bf16x8*>(Ks + KSWZ(32 + r32, cb));
        p0 = __builtin_amdgcn_mfma_f32_32x32x16_bf16(b0, qr[d0], p0, 0, 0, 0);
        p1 = __builtin_amdgcn_mfma_f32_32x32x16_bf16(b1, qr[d0], p1, 0, 0, 0); }
}
DI int v_st(int k, int c) { const int kk = (k & ~0xC) | ((k & 4) << 1) | ((k & 8) >> 1); return ((kk >> 3) * 2 + (c >> 5)) * 512 + ((kk & 7) * 32 + (c & 31)) * 2; }
DI int v_rd_base(int lane) { return ((lane & 3) << 3) | (((lane >> 2) & 3) << 6) | (((lane >> 4) & 1) << 5) | (((lane >> 5) & 1) << 8); }
constexpr int v_rd_off(int d0, int ks, int half) { return d0 * 512 + ks * 2048 + half * 1024; }
template <int OFF> DI s16x4 tr_read(int vb) { s16x4 r; asm volatile("ds_read_b64_tr_b16 %0, %1 offset:%2" : "=&v"(r) : "v"(vb), "i"(OFF) : "memory"); return r; }
template <int D0> DI void pv_one(f32x16& od, int vb, bf16x8 pa0, bf16x8 pa1, bf16x8 pa2, bf16x8 pa3) {
    const s16x4 l0 = tr_read<v_rd_off(D0, 0, 0)>(vb), h0 = tr_read<v_rd_off(D0, 0, 1)>(vb), l1 = tr_read<v_rd_off(D0, 1, 0)>(vb), h1 = tr_read<v_rd_off(D0, 1, 1)>(vb);
    const s16x4 l2 = tr_read<v_rd_off(D0, 2, 0)>(vb), h2 = tr_read<v_rd_off(D0, 2, 1)>(vb), l3 = tr_read<v_rd_off(D0, 3, 0)>(vb), h3 = tr_read<v_rd_off(D0, 3, 1)>(vb);
    asm volatile("s_waitcnt lgkmcnt(0)" ::: "memory"); SBAR();
#define PK(L, H) (bf16x8){L[0], L[1], L[2], L[3], H[0], H[1], H[2], H[3]}
    od = __builtin_amdgcn_mfma_f32_32x32x16_bf16(pa0, PK(l0, h0), od, 0, 0, 0);
    od = __builtin_amdgcn_mfma_f32_32x32x16_bf16(pa1, PK(l1, h1), od, 0, 0, 0);
    od = __builtin_amdgcn_mfma_f32_32x32x16_bf16(pa2, PK(l2, h2), od, 0, 0, 0);
    od = __builtin_amdgcn_mfma_f32_32x32x16_bf16(pa3, PK(l3, h3), od, 0, 0, 0);
#undef PK
}
DI void pv_d0(f32x16* o, int vb, bf16x8 pa0, bf16x8 pa1, bf16x8 pa2, bf16x8 pa3) { pv_one<0>(o[0], vb, pa0, pa1, pa2, pa3); pv_one<1>(o[1], vb, pa0, pa1, pa2, pa3); }

DI void attn_unit(const bf16_t* __restrict__ Qb, const bf16_t* __restrict__ Knh, const bf16_t* __restrict__ KRs, const bf16_t* __restrict__ Vh, bf16_t* __restrict__ Ob, int seq, char* lds) {
    int tid_ = threadIdx.x; asm volatile("" : "+v"(tid_));
    const int tid = tid_, wid = tid >> 6, lane = tid & 63, r32 = lane & 31, hi = lane >> 5;
    char* V_lds = lds; char* K_lds = lds + 3 * SHM_V;
    float* ws = (float*)(lds + 3 * SHM_V + 3 * SHM_K) + wid * 64; float* li_l = ws; float* al_l = ws + 32;
    float m_reg = -1e30f, l_reg = 0; f32x16 o[2] = {}; bf16x8 qr[6];
    const bf16_t* Qw = Qb + (long)(wid * QBLK + r32) * 768 + hi * 8;
#pragma unroll
    for (int d0 = 0; d0 < 6; ++d0) qr[d0] = *reinterpret_cast<const bf16x8*>(Qw + d0 * 16);
    const int sr = tid >> 3, sc = (tid & 7) * 8, vst = v_st(sr, sc), kst = KSWZ(sr, sc * 2);
    const int rrw = (tid & 255) >> 2, rcl = (tid & 3) * 8, krst = KSWZ(rrw, 128 + rcl * 2);
    const bool rwr = tid < 256;
    const int vb0 = (int)(uintptr_t)V_lds + v_rd_base(lane);
    struct { bf16x8 vs, ks, rs; } sr_[1];
#define SLOAD(i, k0) do { sr_[i].vs = *reinterpret_cast<const bf16x8*>(&Vh[(long)((k0) + sr) * 512 + sc]); sr_[i].ks = *reinterpret_cast<const bf16x8*>(&Knh[(long)((k0) + sr) * 512 + sc]); \
    sr_[i].rs = *reinterpret_cast<const bf16x8*>(&KRs[(long)((k0) + rrw) * 32 + rcl]); } while (0)
#define SWRITE(b, i) do { *(bf16x8*)(V_lds + (b) * SHM_V + vst) = sr_[i].vs; *(bf16x8*)(K_lds + (b) * SHM_K + kst) = sr_[i].ks; if (rwr) *(bf16x8*)(K_lds + (b) * SHM_K + krst) = sr_[i].rs; } while (0)
#define SWAIT() asm volatile("s_waitcnt vmcnt(0)" ::: "memory")
#define RESC(a) do { if (__any((a) < 1.f)) { if (hi == 0) al_l[r32] = (a); asm volatile("s_waitcnt lgkmcnt(0)" ::: "memory"); \
    _Pragma("unroll") for (int d = 0; d < 2; ++d) _Pragma("unroll") for (int r = 0; r < 16; ++r) o[d][r] *= al_l[crow(r, hi)]; } } while (0)
    f32x16 pA0, pA1, pB0, pB1; float mnA, mnB, alA, alB; bf16x8 pa0, pa1, pa2, pa3; const int NT = seq / KVBLK;
    int b_prev = 2, b_cur = 0, b_next = 1;
#define ROT3() do { b_prev = b_cur; b_cur = b_next; b_next = (b_next == 2) ? 0 : b_next + 1; } while (0)
#define STEP(PX0, PX1, mnX, alX, PY0, PY1, alY, jj) do { ROT3(); __syncthreads(); \
        SLOAD(0, ((jj) + 1 < NT ? (jj) + 1 : NT - 1) * KVBLK); \
        SBAR(); qkt(PX0, PX1, K_lds + b_cur * SHM_K, qr, r32, hi); \
        finishSM(PY0, PY1, alY, l_reg, pa0, pa1, pa2, pa3); SBAR(); \
        pv_d0(o, vb0 + b_prev * SHM_V, pa0, pa1, pa2, pa3); partialSM(PX0, PX1, m_reg, mnX, alX); \
        RESC(alX); SWAIT(); SWRITE(b_next, 0); } while (0)
    SLOAD(0, 0); asm volatile("s_waitcnt vmcnt(0)" ::: "memory"); SWRITE(0, 0); __syncthreads();
    SLOAD(0, KVBLK);
    qkt(pA0, pA1, K_lds, qr, r32, hi); partialSM(pA0, pA1, m_reg, mnA, alA);
    SWAIT(); SWRITE(1, 0);
    for (int j = 1; j + 1 < NT; j += 2) {
        STEP(pB0, pB1, mnB, alB, pA0, pA1, alA, j);
        STEP(pA0, pA1, mnA, alA, pB0, pB1, alB, j + 1);
    }
    STEP(pB0, pB1, mnB, alB, pA0, pA1, alA, NT - 1);
    finishSM(pB0, pB1, alB, l_reg, pa0, pa1, pa2, pa3); SBAR();
    pv_d0(o, vb0 + b_cur * SHM_V, pa0, pa1, pa2, pa3);
    if (hi == 0) li_l[r32] = l_reg; asm volatile("s_waitcnt lgkmcnt(0)" ::: "memory");
    float rli[16];
#pragma unroll
    for (int r = 0; r < 16; ++r) rli[r] = __builtin_amdgcn_rcpf(li_l[crow(r, hi)]);
    bf16_t* Ow = Ob + (long)(wid * QBLK) * 512;
#pragma unroll
    for (int r = 0; r < 16; ++r) { const int orow = crow(r, hi);
#pragma unroll
        for (int d0 = 0; d0 < 2; ++d0) Ow[(long)orow * 512 + d0 * 32 + r32] = (bf16_t)(cvtpk(o[d0][r] * rli[r], 0.f) & 0xffffu); }
    __syncthreads();
#undef SLOAD
#undef SWRITE
#undef SWAIT
#undef RESC
#undef STEP
#undef ROT3
}
}

#define XB_TMO      128
#define XB_XCNT(j)  (256  + 64 * (j))
#define XB_XSUB(j)  (1280 + 64 * (j))
#define XB_XGEN(j)  (2304 + 64 * (j))
#define XB_TOP      3328
#define XB_TOPGEN   3392
#define XCD_BAR_WORDS 3456
#define XB_SPIN_CAP (1u << 18)

__device__ __forceinline__ unsigned xb_ld(unsigned* p)              { return __hip_atomic_load(p, __ATOMIC_RELAXED, __HIP_MEMORY_SCOPE_AGENT); }
__device__ __forceinline__ unsigned xb_add(unsigned* p, unsigned v) { return __hip_atomic_fetch_add(p, v, __ATOMIC_RELAXED, __HIP_MEMORY_SCOPE_AGENT); }
__device__ __forceinline__ unsigned xb_xcc_id() { return (unsigned)__builtin_amdgcn_s_getreg((3 << 11) | 20) & 0xFu; }
#define XB_SPIN(cond, bar) do { unsigned _sp = 0; while (cond) { __builtin_amdgcn_s_sleep(1); \
    if ((++_sp & 255u) == 0u) { if (xb_ld(&(bar)[XB_TMO])) break; if (_sp > XB_SPIN_CAP) { atomicAdd(&(bar)[XB_TMO], 1u); break; } } } } while (0)

struct XcdBarrier {
    unsigned* bar; unsigned x;
    volatile LAS unsigned* st;
};

__device__ __forceinline__ XcdBarrier xcd_barrier_post(unsigned* bar, volatile LAS unsigned* st) {
    XcdBarrier b; b.bar = bar; b.x = xb_xcc_id(); b.st = st;
    if (threadIdx.x == 0) (void)xb_add(&bar[XB_XCNT(b.x)], 1u);
    return b;
}
__device__ __forceinline__ void xcd_barrier_complete(unsigned* bar, unsigned x, unsigned& nloc, unsigned& nx) {
    const unsigned G = gridDim.x * gridDim.y * gridDim.z;
    unsigned sum, cnt, mine, sp = 0u;
    for (;;) {
        sum = 0u; cnt = 0u; mine = 0u;
#pragma unroll
        for (unsigned j = 0; j < 16; ++j) { const unsigned c = xb_ld(&bar[XB_XCNT(j)]); sum += c; cnt += (c > 0u) ? 1u : 0u; mine = (j == x) ? c : mine; }
        if (sum == G) break;
        __builtin_amdgcn_s_sleep(1);
        if ((++sp & 255u) == 0u) { if (xb_ld(&bar[XB_TMO])) break; if (sp > XB_SPIN_CAP) { atomicAdd(&bar[XB_TMO], 1u); break; } }
    }
    nloc = mine > 0u ? mine : 1u; nx = cnt > 0u ? cnt : 1u;
}

__device__ __forceinline__ void xcd_barrier(const XcdBarrier& b) {
    asm volatile("s_waitcnt vmcnt(0)" ::: "memory");
    __syncthreads();
    if (threadIdx.x == 0) {
        unsigned* bar = b.bar;
        __builtin_amdgcn_s_waitcnt(0);
        unsigned nloc = b.st[0], nx = b.st[1];
        if (nloc == 0u) { xcd_barrier_complete(bar, b.x, nloc, nx); b.st[0] = nloc; b.st[1] = nx; }
        const unsigned old = xb_add(&bar[XB_XSUB(b.x)], 1u);
        const unsigned gen = old / nloc;
        if (old + 1u == (gen + 1u) * nloc) {
            __builtin_amdgcn_fence(__ATOMIC_RELEASE, "agent");
            asm volatile("s_waitcnt vmcnt(0)" ::: "memory");
            const unsigned og = xb_add(&bar[XB_TOP], 1u);
            const unsigned tg = og / nx;
            if (og + 1u == (tg + 1u) * nx) xb_add(&bar[XB_TOPGEN], 1u);
            else XB_SPIN(xb_ld(&bar[XB_TOPGEN]) == tg, bar);
            __builtin_amdgcn_fence(__ATOMIC_ACQUIRE, "agent");
            xb_add(&bar[XB_XGEN(b.x)], 1u);
            asm volatile("s_waitcnt vmcnt(0)" ::: "memory");
        } else {
            XB_SPIN(xb_ld(&bar[XB_XGEN(b.x)]) == gen, bar);
            __builtin_amdgcn_fence(__ATOMIC_ACQUIRE, "agent");
            asm volatile("s_waitcnt vmcnt(0)" ::: "memory");
        }
    }
    __syncthreads();
}


DI int srccol(int id, int n) {
    switch (id) {
        case 0: return n < 384 ? n : (n < 416 ? 384 + ((n - 384) >> 1) + 16 * ((n - 384) & 1) : -1);
        case 1: return 928 + n;
        case 2: return 1952 + n;
        case 3: { const int h = n / 96, d = n - 96 * h; return d < 64 ? h * 96 + d : h * 96 + 64 + ((d - 64) >> 1) + 16 * ((d - 64) & 1); }
        case 4: return n < 512 ? (n >> 6) * 128 + (n & 63) : ((n - 512) >> 6) * 128 + 64 + (n & 63);
        case 6: { const int pn = n >> 8, lo = n & 255; return (lo >> 7) * DFF + pn * 128 + (lo & 127); }
        default: return n;
    }
}
DI void transpose_item(const float* W, int ldw, int K, int N, bf16_t* WT, int id, const float* ks, float cs, LAS float* scr, int item, int lane) {
    const int nblk = N / 32, kb = item / nblk, nb = item - kb * nblk, k0 = 64 * kb, n0 = 32 * nb;
    const int sc = srccol(id, n0 + (lane & 31));
#pragma unroll 8
    for (int i = 0; i < 32; ++i) { const int kk = 2 * i + (lane >> 5); const float g = ks ? ks[k0 + kk] * cs : cs;
        scr[kk * 33 + (lane & 31)] = sc >= 0 ? W[(size_t)(k0 + kk) * ldw + sc] * g : 0.f; }
    asm volatile("s_waitcnt lgkmcnt(0)" ::: "memory");
    const int c = lane & 7;
#pragma unroll
    for (int j = 0; j < 4; ++j) { const int n = (lane >> 3) + 8 * j; const LAS float* s = scr + (8 * c) * 33 + n;
        u32x4 o; o.x = cvtpk(s[0 * 33], s[1 * 33]); o.y = cvtpk(s[2 * 33], s[3 * 33]); o.z = cvtpk(s[4 * 33], s[5 * 33]); o.w = cvtpk(s[6 * 33], s[7 * 33]);
        *(u32x4*)(WT + (size_t)(n0 + n) * K + k0 + 8 * c) = o; }
    asm volatile("s_waitcnt lgkmcnt(0)" ::: "memory");
}

#define GRID_SYNC() do { asm volatile("s_waitcnt vmcnt(0) lgkmcnt(0)" ::: "memory"); grid.sync(); __builtin_amdgcn_fence(__ATOMIC_ACQUIRE, "agent"); asm volatile("s_waitcnt vmcnt(0)" ::: "memory"); __syncthreads(); } while (0)
#define XCD_SYNC() xcd_barrier(xbar)
struct Args { const float* in[17]; float* out; unsigned char* ws; };

__global__ void __launch_bounds__(512, 2) mega_fwd(Args a) {
    extern __shared__ __attribute__((aligned(16))) unsigned char lds_raw[];
    cg::grid_group grid = cg::this_grid();
    LAS unsigned char* lds = (LAS unsigned char*)lds_raw;
    if (threadIdx.x < 4) ((volatile LAS unsigned*)(lds + MISC_OFF))[threadIdx.x] = 0u;
    __syncthreads();
    const int G = gridDim.x, bx = blockIdx.x;
    const int vcu = (G % 8 == 0) ? (bx % 8) * (G / 8) + bx / 8 : bx;
    unsigned char* ws = a.ws;
    const float *xp = a.in[0], *xs = a.in[1], *g_mix = a.in[2], *w_in = a.in[3], *g_q = a.in[4], *w_uq = a.in[5], *g_kv = a.in[6], *w_ukv = a.in[7], *w_ao = a.in[8], *w_fo = a.in[9],
                *w_out = a.in[10], *g_ffn = a.in[11], *w_up = a.in[12], *conv_w = a.in[13], *conv_b = a.in[14], *w_down = a.in[15], *g_final = a.in[16];
    float* out = a.out;
    float *r1 = (float*)(ws + WS_R1), *ssqq = (float*)(ws + WS_SSQQ), *ssqkv = (float*)(ws + WS_SSQKV), *ssq2 = (float*)(ws + WS_SSQ2), *ssq3 = (float*)(ws + WS_SSQ3);
    float *ropec = (float*)(ws + WS_ROPEC), *ropes = (float*)(ws + WS_ROPES);
    bf16_t *WinT = (bf16_t*)(ws + WS_WIN), *WgaT = (bf16_t*)(ws + WS_WGA), *WgfT = (bf16_t*)(ws + WS_WGF), *WuqT = (bf16_t*)(ws + WS_WUQ), *WukvT = (bf16_t*)(ws + WS_WUKV),
           *WaoT = (bf16_t*)(ws + WS_WAO), *WfoT = (bf16_t*)(ws + WS_WFO), *WoT = (bf16_t*)(ws + WS_WO), *WxfT = (bf16_t*)(ws + WS_WXF), *WupT = (bf16_t*)(ws + WS_WUP), *WdT = (bf16_t*)(ws + WS_WD),
           *DFTm = (bf16_t*)(ws + WS_DFT);
    bf16_t *XB = (bf16_t*)(ws + WS_XB), *CQ = (bf16_t*)(ws + WS_CQ), *CKV = (bf16_t*)(ws + WS_CKV), *KR = (bf16_t*)(ws + WS_KR), *Qb = (bf16_t*)(ws + WS_Q), *KN = (bf16_t*)(ws + WS_KN),
           *Vb = (bf16_t*)(ws + WS_V), *Fb = (bf16_t*)(ws + WS_F), *AO = (bf16_t*)(ws + WS_AO), *MIX = (bf16_t*)(ws + WS_MIX), *TMPB = (bf16_t*)(ws + WS_TMP), *ACT = (bf16_t*)(ws + WS_ACT);
    bf16_t *XP = (bf16_t*)((unsigned char*)out + OUT_XP), *P2 = (bf16_t*)((unsigned char*)out + OUT_P2);
    const int NGW = G * NWAVES, GT = G * 512;
    using pg8::Op; using pg8::StaticOrder;

    {
        int tid_ = threadIdx.x; asm volatile("" : "+v"(tid_));
        const int tid = tid_, lane = tid & 63, wave = __builtin_amdgcn_readfirstlane(tid >> 6), gw = vcu * NWAVES + wave, gtid = bx * 512 + tid;
        for (int row = gw; row < T; row += 2 * NGW) {
            const int row2 = row + NGW; const bool has2 = row2 < T; const int rb = has2 ? row2 : row;
            const float* xr = row < TP ? xp + (size_t)row * 1024 : xs + (size_t)(row - TP) * 1024;
            const float* xq = rb < TP ? xp + (size_t)rb * 1024 : xs + (size_t)(rb - TP) * 1024;
            f32x4 v[4], w[4]; float s = 0.f, s2 = 0.f;
#pragma unroll
            for (int j = 0; j < 4; ++j) { v[j] = ((const f32x4*)xr)[lane + 64 * j]; w[j] = ((const f32x4*)xq)[lane + 64 * j]; }
#pragma unroll
            for (int j = 0; j < 4; ++j) { s += pg8::dot4(v[j]); s2 += pg8::dot4(w[j]); }
            s = wave_sum(s); s2 = wave_sum(s2);
            if (lane == 0) { r1[row] = __builtin_amdgcn_rsqf(s * (1.0f / 1024.0f) + EPS); if (has2) r1[row2] = __builtin_amdgcn_rsqf(s2 * (1.0f / 1024.0f) + EPS); }
            u32x2* o8 = (u32x2*)(XB + (size_t)row * 1024) + lane; u32x2* o9 = (u32x2*)(XB + (size_t)rb * 1024) + lane;
#pragma unroll
            for (int j = 0; j < 4; ++j) { u32x2 a; a.x = cvtpk(v[j][0], v[j][1]); a.y = cvtpk(v[j][2], v[j][3]); o8[64 * j] = a; }
            if (has2) {
#pragma unroll
                for (int j = 0; j < 4; ++j) { u32x2 a; a.x = cvtpk(w[j][0], w[j][1]); a.y = cvtpk(w[j][2], w[j][3]); o9[64 * j] = a; } }
        }
        LAS float* scr = (LAS float*)(lds + wave * 8448);
        constexpr int I0 = 16 * 16, I1 = 16 * 32, I3 = 4 * 24, I4 = 2 * 32, I5 = 8 * 32, I7 = 16 * 32, I8 = 16 * 176, I9 = 44 * 32;
        constexpr int NIT = I0 + 2 * I1 + I3 + I4 + 2 * I5 + I7 + I8 + I9;
        const float qscale = 0.10206207261596577f * LOG2E;
        for (int it = gw; it < NIT; it += NGW) {
            int r = it;
            if (r < I0) { transpose_item(w_in, INC, 1024, 512, WinT, 0, g_mix, 1.f, scr, r, lane); continue; } r -= I0;
            if (r < I1) { transpose_item(w_in, INC, 1024, 1024, WgaT, 1, g_mix, 1.f, scr, r, lane); continue; } r -= I1;
            if (r < I1) { transpose_item(w_in, INC, 1024, 1024, WgfT, 2, g_mix, 1.f, scr, r, lane); continue; } r -= I1;
            if (r < I3) { transpose_item(w_uq, 768, 256, 768, WuqT, 3, g_q, qscale, scr, r, lane); continue; } r -= I3;
            if (r < I4) { transpose_item(w_ukv, 1024, 128, 1024, WukvT, 4, g_kv, 1.f, scr, r, lane); continue; } r -= I4;
            if (r < I5) { transpose_item(w_ao, 1024, 512, 1024, WaoT, 5, nullptr, 1.f, scr, r, lane); continue; } r -= I5;
            if (r < I5) { transpose_item(w_fo, 1024, 512, 1024, WfoT, 5, nullptr, 1.f, scr, r, lane); continue; } r -= I5;
            if (r < I7) { transpose_item(w_out, 1024, 1024, 1024, WoT, 5, nullptr, 1.f, scr, r, lane); continue; } r -= I7;
            if (r < I8) { transpose_item(w_up, 2 * DFF, 1024, 2 * DFF, WupT, 6, g_ffn, 1.f, scr, r, lane); continue; } r -= I8;
            transpose_item(w_down, 1024, DFF, 1024, WdT, 5, nullptr, 1.f, scr, r, lane);
        }
        for (int i = gtid; i < 4 * 65536; i += GT) {
            const int mat = i >> 16, rr = (i >> 8) & 255, kk = i & 255; float val = 0.f;
            if (mat == 0) { const int co = rr >> 7, k1 = rr & 127, ci = kk >> 7, n1 = kk & 127; const float rev = (float)((n1 * k1) & 127) * (1.0f / 128.0f);
                const float cs = cos_rev(rev), sn = sin_rev(rev); val = (co == ci ? cs : (co == 0 ? sn : -sn)) * 0.08838834764831845f; }
            else if (mat == 1) { const int co = rr >> 7, h = (rr >> 6) & 1, k1 = rr & 63, h2 = kk >> 7, ci = (kk >> 6) & 1, n1 = kk & 63; const float rev = (float)((n1 * k1) & 63) * (1.0f / 64.0f);
                const float cs = cos_rev(rev), sn = sin_rev(rev); val = (h == h2) ? (co == ci ? cs : (co == 0 ? sn : -sn)) * 0.125f : 0.f; }
            else if (mat == 2) { if (rr < 128) { const int k2 = rr, c = kk >> 7, n2 = kk & 127; const float rev = (float)((n2 * k2) & 127) * (1.0f / 128.0f); val = (c == 0 ? cos_rev(rev) : sin_rev(rev)) * 0.08838834764831845f; } }
            else { if (rr < 128) { const int h = rr >> 6, k2 = rr & 63, h2 = kk >> 7, c = (kk >> 6) & 1, n2 = kk & 63; const float rev = (float)((n2 * k2) & 63) * (1.0f / 64.0f);
                val = (h == h2) ? (c == 0 ? cos_rev(rev) : sin_rev(rev)) * 0.125f : 0.f; } }
            DFTm[i] = (bf16_t)(cvtpk(val, 0.f) & 0xffffu);
        }
        for (int i = gtid; i < 16384 * 16; i += GT) {
            const int pos = i >> 4, k = i & 15;
            const double q4[4] = {1.0, 0.5623413251903491, 0.31622776601683794, 0.1778279410038923};
            double invf = (k & 3) == 0 ? q4[0] : ((k & 3) == 1 ? q4[1] : ((k & 3) == 2 ? q4[2] : q4[3]));
            invf = (k >> 2) == 0 ? invf : ((k >> 2) == 1 ? invf * 0.1 : ((k >> 2) == 2 ? invf * 0.01 : invf * 0.001));
            double rev = (double)pos * invf * 0.15915494309189535; rev = rev - (double)(long long)rev;
            ropec[i] = cos_rev((float)rev); ropes[i] = sin_rev((float)rev);
        }
        for (int i = gtid; i < T; i += GT) { ssqq[i] = 0.f; ssqkv[i] = 0.f; ssq2[i] = 0.f; ssq3[i] = 0.f; }
        for (int i = gtid; i < 384 * 16; i += GT) ((unsigned*)(ws + WS_PCNT))[i] = 0u;
        for (int i = gtid; i < XCD_BAR_WORDS; i += GT) ((unsigned*)(ws + WS_BAR))[i] = 0u;
        __syncthreads();
        for (int it = bx; it < 256; it += G) {
            const int pm = it >> 6, k0 = (it & 63) * 16;
            LAS float* tile = (LAS float*)lds; LAS float* ct = tile + 16 * 129; LAS float* st = ct + 128;
            for (int i = tid; i < 16 * 128; i += 512) { const int kk = i >> 7, cc = i & 127; tile[kk * 129 + cc] = w_in[(size_t)(k0 + kk) * INC + 416 + pm * 128 + cc]; }
            if (tid < 128) { const float rev = (float)tid * (1.0f / 128.0f); ct[tid] = cos_rev(rev); st[tid] = sin_rev(rev); }
            __syncthreads();
            const int kk = tid & 15, wg = tid >> 4; const float gsc = g_mix[k0 + kk] * 0.08838834764831845f;
            for (int wl = wg * 8; wl < wg * 8 + 8; ++wl) {
                const int c = wl >> 7, cp = wl & 127; float s = 0.f;
                for (int cc = 0; cc < 128; ++cc) { const float tv = c == 0 ? ct[(cc * cp) & 127] : st[(cc * cp) & 127]; s += tile[kk * 129 + cc] * tv; }
                if (c == 1) s = -s;
                WxfT[(size_t)(pm * 256 + wl) * 1024 + k0 + kk] = (bf16_t)(cvtpk(s * gsc, 0.f) & 0xffffu);
            }
            __syncthreads();
        }
    }
    GRID_SYNC();
    const XcdBarrier xbar = xcd_barrier_post((unsigned*)(ws + WS_BAR), (volatile LAS unsigned*)(lds + MISC_OFF));

    {
        { Op<0> A{(const char*)XB, 256 * 2048, 2048, 128 * 2048}; Op<0> B{(const char*)WinT, 256 * 2048, 2048, 128 * 2048};
          StaticOrder S; S.init(384, 2, G, bx); pg8::EpiInproj E{r1, CQ, CKV, KR, ssqq, ssqkv, ropec, ropes};
          pg8::gemm_phase(lds, A, B, 1024, S, E); }
        { Op<0> A{(const char*)WxfT, 256 * 2048, 2048, 128 * 2048}; Op<1> B{(const char*)XB, 0, 128 * 2048, 2048};
          StaticOrder S; S.init(4, 128, G, bx); pg8::EpiF1<0> E{r1, XP};
          pg8::gemm_phase(lds, A, B, 1024, S, E); }
        { Op<0> A{(const char*)WxfT, 256 * 2048, 2048, 128 * 2048}; Op<2> B{(const char*)(XB + (size_t)TP * 1024), 0, 0, 32 * 2048};
          StaticOrder S; S.init(4, 256, G, bx); pg8::EpiF1<1> E{r1, XP + (size_t)TP * 1024};
          pg8::gemm_phase(lds, A, B, 1024, S, E); }
    }
    XCD_SYNC();

    {
        { Op<0> A{(const char*)CQ, 256 * 512, 512, 128 * 512}; Op<0> B{(const char*)WuqT, 256 * 512, 512, 128 * 512};
          StaticOrder S; S.init(384, 3, G, bx); pg8::EpiQup E{ssqq, Qb, ropec, ropes};
          pg8::gemm_phase(lds, A, B, 256, S, E); }
        { Op<0> A{(const char*)CKV, 256 * 256, 256, 128 * 256}; Op<0> B{(const char*)WukvT, 256 * 256, 256, 128 * 256};
          StaticOrder S; S.init(384, 4, G, bx); pg8::EpiKVup E{ssqkv, KN, Vb};
          pg8::gemm_phase(lds, A, B, 128, S, E); }
        { Op<0> A{(const char*)DFTm, 0, 512, 128 * 512}; Op<0> B{(const char*)XP, 256 * 512, 512, 128 * 512};
          StaticOrder S; S.init(1, 512, G, bx); pg8::EpiF2<0> E{P2};
          pg8::gemm_phase(lds, A, B, 256, S, E); }
        { Op<0> A{(const char*)(DFTm + 65536), 0, 512, 128 * 512}; Op<0> B{(const char*)(XP + (size_t)TP * 1024), 256 * 512, 512, 128 * 512};
          StaticOrder S; S.init(1, 1024, G, bx); pg8::EpiF2<1> E{P2 + (size_t)TP * 1024};
          pg8::gemm_phase(lds, A, B, 256, S, E); }
    }
    XCD_SYNC();

    {
        { Op<0> A{(const char*)(DFTm + 2 * 65536), 0, 512, 128 * 512}; Op<4> B{(const char*)P2, 256 * 256, 131072, (size_t)128 * 131072};
          StaticOrder S; S.init(1, 512, G, bx); pg8::EpiF3<0> E{Fb};
          pg8::gemm_phase(lds, A, B, 256, S, E); }
        { Op<0> A{(const char*)(DFTm + 3 * 65536), 0, 512, 128 * 512}; Op<4> B{(const char*)(P2 + (size_t)TP * 1024), 256 * 512, 262144, (size_t)128 * 262144};
          StaticOrder S; S.init(1, 1024, G, bx); pg8::EpiF3<1> E{Fb};
          pg8::gemm_phase(lds, A, B, 256, S, E); }
        __syncthreads();
        if (G == 256) {
            for (int i = 0; i < 12; ++i) {
                int base, S, h, qb;
                if (i < 4) { const int p = 2 * (vcu >> 5) + (i >> 1); base = (p >> 3) * 16384; h = p & 7; S = 16384; qb = (vcu & 31) + 32 * (i & 1); }
                else { const int p = (vcu >> 4) * 8 + (i - 4); base = TP + (p >> 3) * 4096; h = p & 7; S = 4096; qb = vcu & 15; }
                att::attn_unit(Qb + (size_t)(base + qb * 256) * 768 + h * 96, KN + (size_t)base * 512 + h * 64, KR + (size_t)base * 32, Vb + (size_t)base * 512 + h * 64,
                               AO + (size_t)(base + qb * 256) * 512 + h * 64, S, (char*)lds_raw);
            }
        } else {
            for (int uidx = bx; uidx < 3072; uidx += G) {
                int base, S, h, qb;
                if (uidx < 1024) { const int p = uidx >> 6; base = (p >> 3) * 16384; h = p & 7; S = 16384; qb = uidx & 63; }
                else { const int v = uidx - 1024, p = v >> 4; base = TP + (p >> 3) * 4096; h = p & 7; S = 4096; qb = v & 15; }
                att::attn_unit(Qb + (size_t)(base + qb * 256) * 768 + h * 96, KN + (size_t)base * 512 + h * 64, KR + (size_t)base * 32, Vb + (size_t)base * 512 + h * 64,
                               AO + (size_t)(base + qb * 256) * 512 + h * 64, S, (char*)lds_raw);
            }
        }
    }
    XCD_SYNC();

    {
        StaticOrder S; S.init(384, 4, G, bx);
        { Op<0> A{(const char*)XB, 256 * 2048, 2048, 128 * 2048}; Op<0> B{(const char*)WgaT, 256 * 2048, 2048, 128 * 2048}; pg8::EpiGate E{r1, MIX}; pg8::gemm_phase(lds, A, B, 1024, S, E); }
        { Op<0> A{(const char*)AO, 256 * 1024, 1024, 128 * 1024}; Op<0> B{(const char*)WaoT, 256 * 1024, 1024, 128 * 1024}; pg8::EpiMix<false> E{MIX, TMPB}; pg8::gemm_phase(lds, A, B, 512, S, E); }
        { Op<0> A{(const char*)XB, 256 * 2048, 2048, 128 * 2048}; Op<0> B{(const char*)WgfT, 256 * 2048, 2048, 128 * 2048}; pg8::EpiGate E{r1, TMPB}; pg8::gemm_phase(lds, A, B, 1024, S, E); }
        { Op<0> A{(const char*)Fb, 256 * 1024, 1024, 128 * 1024}; Op<0> B{(const char*)WfoT, 256 * 1024, 1024, 128 * 1024}; pg8::EpiMix<true> E{MIX, TMPB}; pg8::gemm_phase(lds, A, B, 512, S, E); }
    }
    XCD_SYNC();

    {
        Op<0> A{(const char*)MIX, 256 * 2048, 2048, 128 * 2048}; Op<0> B{(const char*)WoT, 256 * 2048, 2048, 128 * 2048};
        StaticOrder S; S.init(384, 4, G, bx); pg8::EpiRes<true> E{xp, xs, out, XB, ssq2};
        pg8::gemm_phase(lds, A, B, 1024, S, E);
    }
    XCD_SYNC();

    {
        Op<3> A{(const char*)XB, 0, 2048, 128 * 2048}; Op<0> B{(const char*)WupT, 256 * 2048, 2048, 128 * 2048};
        StaticOrder S; S.init(402, 22, G, bx); pg8::EpiUp E{ssq2, conv_w, conv_b, ACT, (LAS float*)(lds + EX_OFF)};
        pg8::gemm_phase(lds, A, B, 1024, S, E);
    }
    XCD_SYNC();

    if (G == 256) {
    {
        Op<0> A{(const char*)ACT, (size_t)256 * DFF * 2, DFF * 2, (size_t)128 * DFF * 2}; Op<0> B{(const char*)WdT, (size_t)256 * DFF * 2, DFF * 2, (size_t)128 * DFF * 2};
        StaticOrder S; S.init(384, 4, G, bx); pg8::EpiFinal E{out, ssq3, (unsigned*)(ws + WS_PCNT), g_final};
        pg8::gemm_phase(lds, A, B, DFF, S, E);
    }
    } else {
    {
        Op<0> A{(const char*)ACT, (size_t)256 * DFF * 2, DFF * 2, (size_t)128 * DFF * 2}; Op<0> B{(const char*)WdT, (size_t)256 * DFF * 2, DFF * 2, (size_t)128 * DFF * 2};
        StaticOrder S; S.init(384, 4, G, bx); pg8::EpiRes<false> E{xp, xs, out, XB, ssq3};
        pg8::gemm_phase(lds, A, B, DFF, S, E);
    }
    XCD_SYNC();

    int tid8 = threadIdx.x; asm volatile("" : "+v"(tid8));
    const int lane = tid8 & 63, gw = vcu * NWAVES + __builtin_amdgcn_readfirstlane(tid8 >> 6);
    for (int row = gw; row < T; row += 2 * NGW) {
        const int row2 = row + NGW; const bool has2 = row2 < T; const int rb = has2 ? row2 : row;
        const float sc = __builtin_amdgcn_rsqf(ssq3[row] * (1.0f / 1024.0f) + EPS), sc2 = __builtin_amdgcn_rsqf(ssq3[rb] * (1.0f / 1024.0f) + EPS);
        f32x4* o = (f32x4*)(out + (size_t)row * 1024) + lane; f32x4* o2 = (f32x4*)(out + (size_t)rb * 1024) + lane;
        f32x4 v[4], w[4];
#pragma unroll
        for (int j = 0; j < 4; ++j) { v[j] = o[64 * j]; w[j] = o2[64 * j]; }
#pragma unroll
        for (int j = 0; j < 4; ++j) { const f32x4 g = ((const f32x4*)g_final)[lane + 64 * j]; o[64 * j] = v[j] * sc * g; if (has2) o2[64 * j] = w[j] * sc2 * g; }
    }
    }
}

extern "C" void kernel_launch(void* const* d_in, const int* in_sizes, int n_in, void* d_out, int out_size, void* d_ws, size_t ws_size, hipStream_t stream) {
    static int grid = 0;
    if (grid == 0) {
        if (n_in != 17 || out_size != T * DM || ws_size < WS_END) { fprintf(stderr, "kernel_launch: unexpected shapes (n_in %d out %d ws %zu)\n", n_in, out_size, ws_size); grid = -1; return; }
        int dev = 0, cus = 0, per_cu = 0;
        if (hipGetDevice(&dev) != hipSuccess || hipDeviceGetAttribute(&cus, hipDeviceAttributeMultiprocessorCount, dev) != hipSuccess) { grid = -1; return; }
        if (hipFuncSetAttribute((const void*)mega_fwd, hipFuncAttributeMaxDynamicSharedMemorySize, LDS_BYTES) != hipSuccess) { fprintf(stderr, "kernel_launch: hipFuncSetAttribute failed\n"); grid = -1; return; }
        if (hipOccupancyMaxActiveBlocksPerMultiprocessor(&per_cu, (const void*)mega_fwd, 512, LDS_BYTES) != hipSuccess || per_cu < 1) { fprintf(stderr, "kernel_launch: occupancy query says %d\n", per_cu); per_cu = 1; }
        (void)hipGetLastError();
        grid = cus * 1;
    }
    if (grid < 0) return;
    Args a{};
    for (int i = 0; i < 17; ++i) a.in[i] = (const float*)d_in[i];
    a.out = (float*)d_out; a.ws = (unsigned char*)d_ws;
    void* args[] = {&a};
    hipError_t e = hipLaunchCooperativeKernel((const void*)mega_fwd, dim3(grid), dim3(512), args, LDS_BYTES, stream);
    if (e != hipSuccess) fprintf(stderr, "kernel_launch: cooperative launch failed: %s (grid %d)\n", hipGetErrorString(e), grid);
}
```

```cpp
#include <hip/hip_runtime.h>
#include <hip/hip_cooperative_groups.h>
#include <cstdio>
#include <cstdint>
namespace cg = cooperative_groups;

#define LAS __attribute__((address_space(3)))
#define DI __device__ __forceinline__
typedef unsigned short bf16_t;
typedef short bf16x8 __attribute__((ext_vector_type(8)));
typedef short s16x4 __attribute__((ext_vector_type(4)));
typedef float f32x2 __attribute__((ext_vector_type(2)));
typedef float f32x4 __attribute__((ext_vector_type(4)));
typedef float f32x16 __attribute__((ext_vector_type(16)));
typedef unsigned u32x2 __attribute__((ext_vector_type(2)));
typedef unsigned u32x4 __attribute__((ext_vector_type(4)));
typedef __bf16 bf16x2_t __attribute__((ext_vector_type(2)));

constexpr int T = 98304, TP = 32768, DM = 1024, INC = 2976, DFF = 2816;
constexpr float EPS = 1e-6f;
constexpr float LOG2E = 1.4426950408889634f;
constexpr int NWAVES = 8;
constexpr size_t MiB = 1ull << 20;
constexpr size_t WS_R1 = 0, WS_SSQQ = 512 * 1024, WS_SSQKV = 1 * MiB, WS_SSQ2 = 1 * MiB + 512 * 1024, WS_SSQ3 = 2 * MiB;
constexpr size_t WS_ROPEC = 4 * MiB, WS_ROPES = 5 * MiB, WS_BAR = 3 * MiB, WS_PCNT = 3 * MiB + 65536;
constexpr size_t WS_WIN = 6 * MiB, WS_WGA = 7 * MiB, WS_WGF = 9 * MiB, WS_WUQ = 11 * MiB, WS_WUKV = 11 * MiB + 512 * 1024, WS_WAO = 12 * MiB, WS_WFO = 13 * MiB,
                 WS_WO = 14 * MiB, WS_WXF = 16 * MiB, WS_WUP = 18 * MiB, WS_WD = 29 * MiB, WS_DFT = 35 * MiB;
constexpr size_t WS_XB = 40 * MiB, WS_CQ = 232 * MiB, WS_CKV = 280 * MiB, WS_KR = 304 * MiB, WS_Q = 316 * MiB, WS_KN = 460 * MiB, WS_V = 556 * MiB,
                 WS_F = 652 * MiB, WS_AO = 748 * MiB, WS_MIX = 232 * MiB, WS_TMP = 424 * MiB, WS_ACT = 232 * MiB, WS_END = 844 * MiB;
constexpr size_t OUT_XP = 0, OUT_P2 = 192 * MiB;
constexpr int RING_BYTES = 131072, EX_OFF = 131072, MISC_OFF = 139264, LDS_BYTES = 147456;

DI unsigned cvtpk(float lo, float hi) { f32x2 v = {lo, hi}; bf16x2_t b = __builtin_convertvector(v, bf16x2_t); return __builtin_bit_cast(unsigned, b); }
DI float bflo(unsigned w) { return __uint_as_float(w << 16); }
DI float bfhi(unsigned w) { return __uint_as_float(w & 0xffff0000u); }
DI float wave_sum(float v) {
#pragma unroll
    for (int o = 1; o < 64; o <<= 1) v += __shfl_xor(v, o);
    return v;
}
DI float sigmoidf_(float v) { return __builtin_amdgcn_rcpf(1.0f + __builtin_amdgcn_exp2f(-v * LOG2E)); }
DI float sin_rev(float r) { return __builtin_amdgcn_sinf(r); }
DI float cos_rev(float r) { return __builtin_amdgcn_cosf(r); }
DI int tok_pos(int row) { return row < TP ? (row & 16383) : ((row - TP) & 4095); }

namespace pg8 {
constexpr int BM = 256, BK = 64, HALF = 128, HTB = HALF * BK * 2, NXCD = 8, WGM = 8;
DI int lds_byte(int r, int c) { const int st = (r >> 4) * 2 + (c >> 5), rr = r & 15, cc = c & 31, ob = rr * 64 + cc * 2; return st * 1024 + (ob ^ (((ob >> 9) & 1) << 5)); }
DI void stage_rc(int b, int& R, int& C) { const int st = b / 1024, sb = b % 1024, swz = sb ^ (((sb >> 9) & 1) << 5); R = (st >> 1) * 16 + swz / 64; C = (st & 1) * 32 + (swz % 64) / 2; }
DI int perm32(int rho) { const int n = rho >> 4, i = rho & 15; return 8 * (i >> 2) + 4 * n + (i & 3); }
struct Unit { int pm, pn; };
struct StaticOrder {
    int nM, nN, nwg, G, c;
    DI void init(int nM_, int nN_, int G_, int c_) { nM = nM_; nN = nN_; nwg = nM * nN; G = G_; c = c_; }
    DI bool next(int i, Unit& u) const {
        const long L = (long)i * G + c; if (L >= nwg) return false;
        int wgid = (int)L; { const int q = nwg / NXCD, r = nwg % NXCD, xcd = wgid % NXCD, off = wgid / NXCD; wgid = (xcd < r ? xcd * (q + 1) : r * (q + 1) + (xcd - r) * q) + off; }
        const int nig = WGM * nN, gid = wgid / nig, fm = gid * WGM, gsz = (nM - fm) < WGM ? (nM - fm) : WGM;
        u.pm = fm + ((wgid % nig) % gsz); u.pn = (wgid % nig) / gsz; return true;
    }
};
DI void up_tile(int pm, int& row0, int& lo, int& hi) {
    int S, base, j;
    if (pm < 130) { const int s = pm / 65; j = pm - s * 65; S = 16384; base = s * 16384; }
    else { const int p = pm - 130; const int s = p / 17; j = p - s * 17; S = 4096; base = TP + s * 4096; }
    int a = 254 * j - 1; a = a < 0 ? 0 : a; a = a > S - 256 ? S - 256 : a;
    row0 = base + a; lo = (a == 0) ? 0 : 1; hi = (a + 256 == S) ? 255 : 254;
}
template <int KIND> struct Op {
    const char* base; size_t tstep; unsigned rstep; size_t hs;
    DI const char* tile(int p) const {
        if (KIND == 0) return base + (size_t)p * tstep;
        if (KIND == 1) return base + (size_t)((p >> 6) * 16384 + 2 * (p & 63)) * 2048;
        if (KIND == 2) return base + (size_t)((p >> 4) * 4096 + 2 * (p & 15)) * 2048;
        if (KIND == 3) { int row0, lo, hi; up_tile(p, row0, lo, hi); return base + (size_t)row0 * 2048; }
        return base + ((size_t)(p & 1) * tstep + (size_t)(p >> 1)) * 512;
    }
    DI unsigned rowoff(int R) const {
        if (KIND == 2) return (unsigned)(64 * (R & 63) + (R >> 6)) * 2048u;
        return (unsigned)R * rstep;
    }
};

template <class Epi, class OA, class OB>
DI void gemm_phase(LAS unsigned char* lds, const OA PA, const OB PB, const int K, const StaticOrder& S, const Epi& E) {
    int tid_ = threadIdx.x; asm volatile("" : "+v"(tid_));
    const int tid = tid_, wid = __builtin_amdgcn_readfirstlane(tid >> 6), lane = tid & 63, wr = wid >> 2, wc = wid & 3, fr = lane & 15, fq = lane >> 4;
    int nt_ = K / BK; asm volatile("" : "+s"(nt_)); const int nt = nt_;
    unsigned voffA[2], voffB[2];
#pragma unroll
    for (int i = 0; i < 2; ++i) { int R, C; stage_rc(tid * 16 + i * 8192, R, C); const int Rb = (R & ~31) + perm32(R & 31);
        voffA[i] = PA.rowoff(R) + (unsigned)C * 2u; voffB[i] = PB.rowoff(Rb) + (unsigned)C * 2u; }
    const size_t kstep = (size_t)(BK * 2);
    const size_t hsA = PA.hs, hsB = PB.hs;
    const unsigned ldsw = (unsigned)wid * 1024u;
    const int aoff = lds_byte(wr * 64 + fr, fq * 8), boff = lds_byte(wc * 32 + fr, fq * 8);
#define PG8_SA(b, h) (((b) * 2 + (h)) * HTB)
#define PG8_SB(b, h) ((4 + (b) * 2 + (h)) * HTB)
#define PG8_STAGE(bufoff, gbase, voff) do { _Pragma("unroll") for (int _i = 0; _i < 2; ++_i) \
        __builtin_amdgcn_global_load_lds((const unsigned*)((const char*)(gbase) + (voff)[_i]), (LAS unsigned*)(lds + (bufoff) + ldsw + _i * 8192), 16, 0, 0); } while (0)
#define PG8_LDA(dst, b, h) do { _Pragma("unroll") for (int m = 0; m < 4; ++m) _Pragma("unroll") for (int k = 0; k < 2; ++k) dst[m][k] = *(const LAS bf16x8*)(lds + PG8_SA(b, h) + aoff + m * 2048 + k * 1024); } while (0)
#define PG8_LDB(dst, b, h) do { _Pragma("unroll") for (int n = 0; n < 2; ++n) _Pragma("unroll") for (int k = 0; k < 2; ++k) dst[n][k] = *(const LAS bf16x8*)(lds + PG8_SB(b, h) + boff + n * 2048 + k * 1024); } while (0)
#define PG8_MMA(ai, bj, At, Bt) do { __builtin_amdgcn_s_setprio(1); _Pragma("unroll") for (int m = 0; m < 4; ++m) _Pragma("unroll") for (int n = 0; n < 2; ++n) _Pragma("unroll") for (int k = 0; k < 2; ++k) \
        acc[ai][bj][m][n] = __builtin_amdgcn_mfma_f32_16x16x32_bf16(Bt[n][k], At[m][k], acc[ai][bj][m][n], 0, 0, 0); __builtin_amdgcn_s_setprio(0); } while (0)
#define PG8_WAIT_V(n) asm volatile("s_waitcnt vmcnt(" #n ")" ::: "memory")
#define PG8_WAIT_L(n) asm volatile("s_waitcnt lgkmcnt(" #n ")" ::: "memory")
#define PG8_BAR __builtin_amdgcn_s_barrier()
#define PG8_SCHED __builtin_amdgcn_sched_barrier(0)
    Unit cur, nxt; int ui = 0;
    if (!S.next(0, cur)) return;
    f32x4 acc[2][2][4][2];
#pragma unroll
    for (int a = 0; a < 2; ++a)
#pragma unroll
        for (int b = 0; b < 2; ++b)
#pragma unroll
            for (int m = 0; m < 4; ++m)
#pragma unroll
                for (int n = 0; n < 2; ++n) acc[a][b][m][n] = (f32x4){0.f, 0.f, 0.f, 0.f};
    bf16x8 At[4][2], B0[2][2], B1[2][2];
    const char* cA = PA.tile(cur.pm); const char* cB = PB.tile(cur.pn);
    asm volatile("" : "+s"(cA), "+s"(cB));
    PG8_STAGE(PG8_SB(0, 0), cB, voffB); PG8_STAGE(PG8_SB(0, 1), cB + hsB, voffB); PG8_STAGE(PG8_SA(0, 0), cA, voffA); PG8_STAGE(PG8_SA(0, 1), cA + hsA, voffA);
    if (wr == 1) PG8_BAR;
    PG8_WAIT_V(2); PG8_BAR;
    PG8_STAGE(PG8_SB(1, 0), cB + kstep, voffB); PG8_STAGE(PG8_SA(1, 0), cA + kstep, voffA); PG8_STAGE(PG8_SB(1, 1), cB + hsB + kstep, voffB);
    PG8_WAIT_V(6); PG8_BAR;
    for (;;) {
        const bool has_next = S.next(ui + 1, nxt);
        const char* nA = has_next ? PA.tile(nxt.pm) : cA; const char* nB = has_next ? PB.tile(nxt.pn) : cB;
        asm volatile("" : "+s"(nA), "+s"(nB));
        for (int t = 0; t < nt; t += 2) {
            const bool last = (t == nt - 2);
            const char* a1 = cA + (size_t)(t + 1) * kstep;
            const char* a2 = last ? nA : cA + (size_t)(t + 2) * kstep; const char* b2 = last ? nB : cB + (size_t)(t + 2) * kstep;
            const char* a3 = a2 + kstep; const char* b3 = b2 + kstep;
            PG8_LDB(B0, 0, 0); PG8_LDB(B1, 0, 1); PG8_SCHED; PG8_LDA(At, 0, 0); PG8_STAGE(PG8_SA(1, 1), a1 + hsA, voffA);
            PG8_WAIT_V(8); PG8_WAIT_L(0); PG8_BAR; PG8_MMA(0, 0, At, B0); PG8_MMA(0, 1, At, B1); PG8_BAR; PG8_SCHED;
            PG8_LDA(At, 0, 1); PG8_STAGE(PG8_SB(0, 0), b2, voffB); PG8_STAGE(PG8_SB(0, 1), b2 + hsB, voffB); PG8_STAGE(PG8_SA(0, 0), a2, voffA);
            PG8_WAIT_V(8); PG8_WAIT_L(0); PG8_BAR; PG8_MMA(1, 0, At, B0); PG8_MMA(1, 1, At, B1); PG8_BAR; PG8_SCHED;
            PG8_LDB(B0, 1, 0); PG8_LDB(B1, 1, 1); PG8_SCHED; PG8_LDA(At, 1, 0); PG8_STAGE(PG8_SA(0, 1), a2 + hsA, voffA);
            PG8_WAIT_V(8); PG8_WAIT_L(0); PG8_BAR; PG8_MMA(0, 0, At, B0); PG8_MMA(0, 1, At, B1); PG8_BAR; PG8_SCHED;
            PG8_LDA(At, 1, 1); PG8_STAGE(PG8_SB(1, 0), b3, voffB); PG8_STAGE(PG8_SB(1, 1), b3 + hsB, voffB); PG8_STAGE(PG8_SA(1, 0), a3, voffA);
            PG8_WAIT_V(8); PG8_WAIT_L(0); PG8_BAR; PG8_MMA(1, 0, At, B0); PG8_MMA(1, 1, At, B1); PG8_BAR; PG8_SCHED;
        }
        if (wr == 0) PG8_BAR;
        E(acc, cur, wr, wc, fr, fq);
        if (!has_next) break;
#pragma unroll
        for (int a = 0; a < 2; ++a)
#pragma unroll
            for (int b = 0; b < 2; ++b)
#pragma unroll
                for (int m = 0; m < 4; ++m)
#pragma unroll
                    for (int n = 0; n < 2; ++n) acc[a][b][m][n] = (f32x4){0.f, 0.f, 0.f, 0.f};
        cur = nxt; cA = nA; cB = nB; ++ui;
        if (wr == 1) PG8_BAR;
    }
    PG8_WAIT_V(0);
    PG8_BAR;
#undef PG8_SA
#undef PG8_SB
#undef PG8_STAGE
#undef PG8_LDA
#undef PG8_LDB
#undef PG8_MMA
#undef PG8_WAIT_V
#undef PG8_WAIT_L
#undef PG8_BAR
#undef PG8_SCHED
}

typedef f32x4 Acc[2][2][4][2];
#define EPI_LOOP_AI_M _Pragma("unroll") for (int ai = 0; ai < 2; ++ai) _Pragma("unroll") for (int m = 0; m < 4; ++m)
DI u32x4 pack8(f32x4 v0, f32x4 v1) { u32x4 w; w.x = cvtpk(v0[0], v0[1]); w.y = cvtpk(v0[2], v0[3]); w.z = cvtpk(v1[0], v1[1]); w.w = cvtpk(v1[2], v1[3]); return w; }
DI float dot4(f32x4 v) { return (v[0] * v[0] + v[1] * v[1]) + (v[2] * v[2] + v[3] * v[3]); }
DI f32x4 rope4(f32x4 v, const float* rc, const float* rs, int pos, int i0) {
    const f32x2 c = *(const f32x2*)(rc + pos * 16 + i0), s = *(const f32x2*)(rs + pos * 16 + i0);
    f32x4 o; o[0] = v[0] * c[0] - v[1] * s[0]; o[1] = v[1] * c[0] + v[0] * s[0]; o[2] = v[2] * c[1] - v[3] * s[1]; o[3] = v[3] * c[1] + v[2] * s[1]; return o;
}

struct EpiInproj {
    const float* r1; bf16_t* CQ; bf16_t* CKV; bf16_t* KR; float* ssqq; float* ssqkv; const float* rc; const float* rs;
    DI void operator()(Acc& acc, const Unit& u, int wr, int wc, int fr, int fq) const {
        float scv[2][4];
        EPI_LOOP_AI_M scv[ai][m] = r1[u.pm * 256 + ai * 128 + wr * 64 + m * 16 + fr];
        EPI_LOOP_AI_M {
            const int row = u.pm * 256 + ai * 128 + wr * 64 + m * 16 + fr; const float sc = scv[ai][m]; float ss = 0.f;
#pragma unroll
            for (int bj = 0; bj < 2; ++bj) {
                f32x4 v0 = acc[ai][bj][m][0] * sc, v1 = acc[ai][bj][m][1] * sc; const int cl = bj * 128 + wc * 32 + 8 * fq;
                if (u.pn == 0) { ss += dot4(v0) + dot4(v1); *(u32x4*)(CQ + (size_t)row * 256 + cl) = pack8(v0, v1); }
                else if (bj == 0) { ss += dot4(v0) + dot4(v1); *(u32x4*)(CKV + (size_t)row * 128 + cl) = pack8(v0, v1); }
                else if (wc == 0) { const int pos = tok_pos(row); v0 = rope4(v0, rc, rs, pos, 4 * fq); v1 = rope4(v1, rc, rs, pos, 4 * fq + 2);
                    *(u32x4*)(KR + (size_t)row * 32 + 8 * fq) = pack8(v0, v1); }
            }
            ss += __shfl_xor(ss, 16); ss += __shfl_xor(ss, 32);
            if (fq == 0) atomicAdd((u.pn == 0 ? ssqq : ssqkv) + row, ss);
        }
    }
};
struct EpiQup {
    const float* ssqq; bf16_t* Q; const float* rc; const float* rs;
    DI void operator()(Acc& acc, const Unit& u, int wr, int wc, int fr, int fq) const {
        float scv[2][4];
        EPI_LOOP_AI_M scv[ai][m] = ssqq[u.pm * 256 + ai * 128 + wr * 64 + m * 16 + fr];
        EPI_LOOP_AI_M {
            const int row = u.pm * 256 + ai * 128 + wr * 64 + m * 16 + fr; const float sc = __builtin_amdgcn_rsqf(scv[ai][m] * (1.0f / 256.0f) + EPS); const int pos = tok_pos(row);
#pragma unroll
            for (int bj = 0; bj < 2; ++bj) {
                const int c0 = u.pn * 256 + bj * 128 + wc * 32 + 8 * fq; f32x4 v[2];
#pragma unroll
                for (int n = 0; n < 2; ++n) { v[n] = acc[ai][bj][m][n] * sc; const int c4 = c0 + 4 * n, h = c4 / 96, d = c4 - 96 * h;
                    if (d >= 64) v[n] = rope4(v[n], rc, rs, pos, (d - 64) >> 1); }
                *(u32x4*)(Q + (size_t)row * 768 + c0) = pack8(v[0], v[1]);
                asm volatile("" ::: "memory"); __builtin_amdgcn_sched_barrier(0);
            }
        }
    }
};
struct EpiKVup {
    const float* ssqkv; bf16_t* KN; bf16_t* V;
    DI void operator()(Acc& acc, const Unit& u, int wr, int wc, int fr, int fq) const {
        bf16_t* dst = (u.pn < 2 ? KN : V) + (u.pn & 1) * 256;
        float scv[2][4];
        EPI_LOOP_AI_M scv[ai][m] = ssqkv[u.pm * 256 + ai * 128 + wr * 64 + m * 16 + fr];
        EPI_LOOP_AI_M {
            const int row = u.pm * 256 + ai * 128 + wr * 64 + m * 16 + fr; const float sc = __builtin_amdgcn_rsqf(scv[ai][m] * (1.0f / 128.0f) + EPS);
#pragma unroll
            for (int bj = 0; bj < 2; ++bj) *(u32x4*)(dst + (size_t)row * 512 + bj * 128 + wc * 32 + 8 * fq) = pack8(acc[ai][bj][m][0] * sc, acc[ai][bj][m][1] * sc);
        }
    }
};
struct EpiGate {
    const float* r1; bf16_t* DST;
    DI void operator()(Acc& acc, const Unit& u, int wr, int wc, int fr, int fq) const {
        float scv[2][4];
        EPI_LOOP_AI_M scv[ai][m] = r1[u.pm * 256 + ai * 128 + wr * 64 + m * 16 + fr];
        EPI_LOOP_AI_M {
            const int row = u.pm * 256 + ai * 128 + wr * 64 + m * 16 + fr; const float sc = scv[ai][m];
#pragma unroll
            for (int bj = 0; bj < 2; ++bj) { f32x4 v0 = acc[ai][bj][m][0] * sc, v1 = acc[ai][bj][m][1] * sc;
#pragma unroll
                for (int e = 0; e < 4; ++e) { v0[e] = sigmoidf_(v0[e]); v1[e] = sigmoidf_(v1[e]); }
                *(u32x4*)(DST + (size_t)row * 1024 + u.pn * 256 + bj * 128 + wc * 32 + 8 * fq) = pack8(v0, v1); }
        }
    }
};
template <bool FMA> struct EpiMix {
    bf16_t* MIX; const bf16_t* TMPB;
    DI void operator()(Acc& acc, const Unit& u, int wr, int wc, int fr, int fq) const {
#pragma unroll
        for (int ai = 0; ai < 2; ++ai) {
            u32x4 wv[4][2], gv[4][2];
#pragma unroll
            for (int m = 0; m < 4; ++m)
#pragma unroll
                for (int bj = 0; bj < 2; ++bj) { const size_t off = (size_t)(u.pm * 256 + ai * 128 + wr * 64 + m * 16 + fr) * 1024 + u.pn * 256 + bj * 128 + wc * 32 + 8 * fq;
                    wv[m][bj] = *(const u32x4*)(MIX + off); if (FMA) gv[m][bj] = *(const u32x4*)(TMPB + off); }
#pragma unroll
            for (int m = 0; m < 4; ++m)
#pragma unroll
                for (int bj = 0; bj < 2; ++bj) { const size_t off = (size_t)(u.pm * 256 + ai * 128 + wr * 64 + m * 16 + fr) * 1024 + u.pn * 256 + bj * 128 + wc * 32 + 8 * fq;
                    const u32x4 w = wv[m][bj]; const f32x4 a0 = acc[ai][bj][m][0], a1 = acc[ai][bj][m][1]; f32x4 v0, v1;
                    if (FMA) { const u32x4 g = gv[m][bj];
                        v0 = (f32x4){bflo(w.x) + bflo(g.x) * a0[0], bfhi(w.x) + bfhi(g.x) * a0[1], bflo(w.y) + bflo(g.y) * a0[2], bfhi(w.y) + bfhi(g.y) * a0[3]};
                        v1 = (f32x4){bflo(w.z) + bflo(g.z) * a1[0], bfhi(w.z) + bfhi(g.z) * a1[1], bflo(w.w) + bflo(g.w) * a1[2], bfhi(w.w) + bfhi(g.w) * a1[3]};
                    } else {
                        v0 = (f32x4){bflo(w.x) * a0[0], bfhi(w.x) * a0[1], bflo(w.y) * a0[2], bfhi(w.y) * a0[3]};
                        v1 = (f32x4){bflo(w.z) * a1[0], bfhi(w.z) * a1[1], bflo(w.w) * a1[2], bfhi(w.w) * a1[3]};
                    }
                    *(u32x4*)(MIX + off) = pack8(v0, v1); }
        }
    }
};
template <bool WB> struct EpiRes {
    const float* xp; const float* xs; float* out; bf16_t* XB1; float* ssq;
    DI void operator()(Acc& acc, const Unit& u, int wr, int wc, int fr, int fq) const {
#pragma unroll
        for (int ai = 0; ai < 2; ++ai) {
            f32x4 pre[4][2][2];
#pragma unroll
            for (int m = 0; m < 4; ++m) { const int row = u.pm * 256 + ai * 128 + wr * 64 + m * 16 + fr;
                const float* brow = WB ? (row < TP ? xp + (size_t)row * 1024 : xs + (size_t)(row - TP) * 1024) : out + (size_t)row * 1024;
#pragma unroll
                for (int bj = 0; bj < 2; ++bj) { const int c0 = u.pn * 256 + bj * 128 + wc * 32 + 8 * fq; pre[m][bj][0] = *(const f32x4*)(brow + c0); pre[m][bj][1] = *(const f32x4*)(brow + c0 + 4); } }
#pragma unroll
            for (int m = 0; m < 4; ++m) { const int row = u.pm * 256 + ai * 128 + wr * 64 + m * 16 + fr; float ss = 0.f;
#pragma unroll
                for (int bj = 0; bj < 2; ++bj) { const int c0 = u.pn * 256 + bj * 128 + wc * 32 + 8 * fq;
                    const f32x4 v0 = pre[m][bj][0] + acc[ai][bj][m][0], v1 = pre[m][bj][1] + acc[ai][bj][m][1];
                    *(f32x4*)(out + (size_t)row * 1024 + c0) = v0; *(f32x4*)(out + (size_t)row * 1024 + c0 + 4) = v1; ss += dot4(v0) + dot4(v1);
                    if (WB) *(u32x4*)(XB1 + (size_t)row * 1024 + c0) = pack8(v0, v1); }
                ss += __shfl_xor(ss, 16); ss += __shfl_xor(ss, 32);
                if (fq == 0) atomicAdd(ssq + row, ss); }
        }
    }
};
struct EpiFinal {
    float* out; float* ssq; unsigned* cnt; const float* gfin;
    DI void operator()(Acc& acc, const Unit& u, int wr, int wc, int fr, int fq) const {
#pragma unroll
        for (int ai = 0; ai < 2; ++ai) {
            f32x4 pre[4][2][2];
#pragma unroll
            for (int m = 0; m < 4; ++m) { const float* brow = out + (size_t)(u.pm * 256 + ai * 128 + wr * 64 + m * 16 + fr) * 1024;
#pragma unroll
                for (int bj = 0; bj < 2; ++bj) { const int c0 = u.pn * 256 + bj * 128 + wc * 32 + 8 * fq; pre[m][bj][0] = *(const f32x4*)(brow + c0); pre[m][bj][1] = *(const f32x4*)(brow + c0 + 4); } }
#pragma unroll
            for (int m = 0; m < 4; ++m) { const int row = u.pm * 256 + ai * 128 + wr * 64 + m * 16 + fr; float ss = 0.f;
#pragma unroll
                for (int bj = 0; bj < 2; ++bj) { acc[ai][bj][m][0] += pre[m][bj][0]; acc[ai][bj][m][1] += pre[m][bj][1]; ss += dot4(acc[ai][bj][m][0]) + dot4(acc[ai][bj][m][1]); }
                ss += __shfl_xor(ss, 16); ss += __shfl_xor(ss, 32);
                if (fq == 0) atomicAdd(ssq + row, ss); }
        }
        asm volatile("s_waitcnt vmcnt(0)" ::: "memory");
        unsigned* c = cnt + 16 * u.pm;
        if (fr == 0 && fq == 0) __hip_atomic_fetch_add(c, 1u, __ATOMIC_RELAXED, __HIP_MEMORY_SCOPE_AGENT);
        for (unsigned it = 0; it < (1u << 22); ++it) {
            if ((unsigned)__builtin_amdgcn_readfirstlane((int)__hip_atomic_load(c, __ATOMIC_RELAXED, __HIP_MEMORY_SCOPE_AGENT)) >= 32u) break;
            __builtin_amdgcn_s_sleep(2);
        }
        asm volatile("" ::: "memory");
        EPI_LOOP_AI_M {
            const int row = u.pm * 256 + ai * 128 + wr * 64 + m * 16 + fr;
            const float sc = __builtin_amdgcn_rsqf(__hip_atomic_load(ssq + row, __ATOMIC_RELAXED, __HIP_MEMORY_SCOPE_AGENT) * (1.0f / 1024.0f) + EPS);
#pragma unroll
            for (int bj = 0; bj < 2; ++bj) { const int c0 = u.pn * 256 + bj * 128 + wc * 32 + 8 * fq;
                *(f32x4*)(out + (size_t)row * 1024 + c0) = acc[ai][bj][m][0] * sc * *(const f32x4*)(gfin + c0);
                *(f32x4*)(out + (size_t)row * 1024 + c0 + 4) = acc[ai][bj][m][1] * sc * *(const f32x4*)(gfin + c0 + 4); }
        }
    }
};
template <int TYPE> struct EpiF1 {
    const float* r1; bf16_t* XP;
    DI void operator()(Acc& acc, const Unit& u, int wr, int wc, int fr, int fq) const {
        float rr[2][8]; int b, n2b, n10;
        if (TYPE == 0) { b = u.pn >> 6; n2b = 2 * (u.pn & 63); n10 = wc * 32 + 8 * fq; }
        else { b = u.pn >> 4; n2b = 2 * (u.pn & 15) + (wc >> 1); n10 = (wc & 1) * 32 + 8 * fq; }
#pragma unroll
        for (int bj = 0; bj < 2; ++bj)
#pragma unroll
            for (int e = 0; e < 8; ++e) { const int t = (TYPE == 0) ? b * 16384 + 128 * (n10 + e) + n2b + bj : TP + b * 4096 + 64 * (n10 + e) + n2b + 32 * bj; rr[bj][e] = r1[t]; }
        EPI_LOOP_AI_M {
            const int ch = 128 * u.pm + wr * 64 + m * 16 + fr;
#pragma unroll
            for (int bj = 0; bj < 2; ++bj) {
                const size_t addr = (TYPE == 0) ? ((size_t)((ch * 2 + b) * 128 + n2b + bj)) * 256 + ai * 128 + n10
                                                : ((size_t)(((ch * 16 + b) * 32 + n2b) * 2 + bj)) * 128 + ai * 64 + n10;
                f32x4 v0 = acc[ai][bj][m][0], v1 = acc[ai][bj][m][1];
#pragma unroll
                for (int e = 0; e < 4; ++e) { v0[e] *= rr[bj][e]; v1[e] *= rr[bj][4 + e]; }
                *(u32x4*)(XP + addr) = pack8(v0, v1);
            }
        }
    }
};
template <int TYPE> struct EpiF2 {
    bf16_t* P2;
    DI void operator()(Acc& acc, const Unit& u, int wr, int wc, int fr_, int fq) const {
        int fr = fr_; asm volatile("" : "+v"(fr));
#pragma unroll
        for (int m = 0; m < 4; ++m) {
#pragma unroll
            for (int bj = 0; bj < 2; ++bj) {
                int k1, n20, chb; size_t addr;
                if (TYPE == 0) { k1 = wr * 64 + m * 16 + fr; n20 = wc * 32 + 8 * fq; chb = 2 * u.pn + bj; addr = ((size_t)chb * 128 + k1) * 256 + n20; }
                else { k1 = m * 16 + fr; n20 = 32 * wr + 8 * fq; chb = 8 * u.pn + bj * 4 + wc; addr = ((size_t)chb * 32 + (k1 & 31)) * 256 + (k1 >> 5) * 128 + n20; }
#pragma unroll
                for (int n = 0; n < 2; ++n) {
                    float pr[4], pi[4];
#pragma unroll
                    for (int e = 0; e < 4; ++e) { const int n2 = n20 + 4 * n + e;
                        const float rev = (TYPE == 0) ? (float)((n2 * k1) & 16383) * (1.0f / 16384.0f) : (float)((n2 * k1) & 4095) * (1.0f / 4096.0f);
                        const float cs = cos_rev(rev), sn = sin_rev(rev), ar = acc[0][bj][m][n][e], aim = acc[1][bj][m][n][e];
                        pr[e] = ar * cs + aim * sn; pi[e] = aim * cs - ar * sn; }
                    u32x2 w0, w1; w0.x = cvtpk(pr[0], pr[1]); w0.y = cvtpk(pr[2], pr[3]); w1.x = cvtpk(pi[0], pi[1]); w1.y = cvtpk(pi[2], pi[3]);
                    *(u32x2*)(P2 + addr + 4 * n) = w0;
                    *(u32x2*)(P2 + addr + 4 * n + (TYPE == 0 ? 128 : 64)) = w1;
                    asm volatile("" ::: "memory"); __builtin_amdgcn_sched_barrier(0);
                }
            }
        }
    }
};
template <int TYPE> struct EpiF3 {
    bf16_t* Fo;
    DI void operator()(Acc& acc, const Unit& u, int wr, int wc, int fr, int fq) const {
        const int bk = u.pn >> 1, chh = (u.pn & 1) * 256;
#pragma unroll
        for (int m = 0; m < 4; ++m) {
            int tok;
            if (TYPE == 0) { const int b = bk >> 7, k1 = bk & 127, k2 = wr * 64 + m * 16 + fr; tok = b * 16384 + k1 + 128 * k2; }
            else { const int b = bk >> 5, k1 = (bk & 31) + 32 * wr, k2 = m * 16 + fr; tok = TP + b * 4096 + k1 + 64 * k2; }
#pragma unroll
            for (int bj = 0; bj < 2; ++bj) *(u32x4*)(Fo + (size_t)tok * 512 + chh + bj * 128 + wc * 32 + 8 * fq) = pack8(acc[0][bj][m][0], acc[0][bj][m][1]);
        }
    }
};
DI float dpp_up(float prev, float cur) { return __int_as_float(__builtin_amdgcn_update_dpp(__float_as_int(prev), __float_as_int(cur), 0x111, 0xf, 0xf, false)); }
DI float dpp_dn(float next, float cur) { return __int_as_float(__builtin_amdgcn_update_dpp(__float_as_int(next), __float_as_int(cur), 0x101, 0xf, 0xf, false)); }
DI float ror1(float x) { return __int_as_float(__builtin_amdgcn_update_dpp(0, __float_as_int(x), 0x121, 0xf, 0xf, false)); }
DI float ror15(float x) { return __int_as_float(__builtin_amdgcn_update_dpp(0, __float_as_int(x), 0x12F, 0xf, 0xf, false)); }
struct EpiUp {
    const float* ssq2; const float* cw; const float* cb; bf16_t* ACT; LAS float* ex;
    DI void operator()(Acc& acc, const Unit& u, int wr, int wc, int fr, int fq) const {
        int row0, lo, hi; up_tile(u.pm, row0, lo, hi);
        f32x4 w0[2], w1[2], w2[2], bb[2];
#pragma unroll
        for (int bj = 0; bj < 2; ++bj) { const int c = bj * DFF + u.pn * 128 + wc * 32 + 8 * fq; w0[bj] = *(const f32x4*)(cw + c); w1[bj] = *(const f32x4*)(cw + 2 * DFF + c); w2[bj] = *(const f32x4*)(cw + 4 * DFF + c); bb[bj] = *(const f32x4*)(cb + c); }
        float scv[2][4];
        EPI_LOOP_AI_M scv[ai][m] = ssq2[row0 + ai * 128 + wr * 64 + m * 16 + fr];
        EPI_LOOP_AI_M { const float sc = __builtin_amdgcn_rsqf(scv[ai][m] * (1.0f / 1024.0f) + EPS);
#pragma unroll
            for (int bj = 0; bj < 2; ++bj) { acc[ai][bj][m][0] *= sc; acc[ai][bj][m][1] *= sc; } }
#pragma unroll
        for (int ai = 0; ai < 2; ++ai)
#pragma unroll
            for (int bj = 0; bj < 2; ++bj)
#pragma unroll
                for (int n = 0; n < 2; ++n) { const int col = bj * 128 + wc * 32 + 8 * fq + 4 * n, blk = ai * 2 + wr;
                    if (fr == 0) *(LAS f32x4*)(ex + (blk * 2 + 0) * 256 + col) = acc[ai][bj][0][n];
                    if (fr == 15) *(LAS f32x4*)(ex + (blk * 2 + 1) * 256 + col) = acc[ai][bj][3][n]; }
        asm volatile("s_waitcnt lgkmcnt(0)" ::: "memory"); __builtin_amdgcn_s_barrier(); asm volatile("" ::: "memory");
#pragma unroll
        for (int n = 0; n < 2; ++n) {
            const int cl = wc * 32 + 8 * fq + 4 * n, cgc = u.pn * 128 + cl;
            if (n == 1) {
#pragma unroll
                for (int bj = 0; bj < 2; ++bj) { const int c = bj * DFF + cgc; w0[bj] = *(const f32x4*)(cw + c); w1[bj] = *(const f32x4*)(cw + 2 * DFF + c); w2[bj] = *(const f32x4*)(cw + 4 * DFF + c); bb[bj] = *(const f32x4*)(cb + c); } }
#pragma unroll
            for (int ai = 0; ai < 2; ++ai) {
                const int blk = ai * 2 + wr; f32x4 eu[2], ed[2];
#pragma unroll
                for (int bj = 0; bj < 2; ++bj) { const int col = bj * 128 + cl;
                    eu[bj] = blk > 0 ? *(const LAS f32x4*)(ex + ((blk - 1) * 2 + 1) * 256 + col) : (f32x4){0.f, 0.f, 0.f, 0.f};
                    ed[bj] = blk < 3 ? *(const LAS f32x4*)(ex + ((blk + 1) * 2 + 0) * 256 + col) : (f32x4){0.f, 0.f, 0.f, 0.f}; }
#pragma unroll
                for (int m = 0; m < 4; ++m) {
                    float cv[2][4];
#pragma unroll
                    for (int bj = 0; bj < 2; ++bj)
#pragma unroll
                        for (int e = 0; e < 4; ++e) { const float cur = acc[ai][bj][m][n][e];
                            const float prev = (m > 0) ? ror1(acc[ai][bj][m > 0 ? m - 1 : 0][n][e]) : eu[bj][e];
                            const float next = (m < 3) ? ror15(acc[ai][bj][m < 3 ? m + 1 : 3][n][e]) : ed[bj][e];
                            const float up = dpp_up(prev, cur), dn = dpp_dn(next, cur);
                            cv[bj][e] = w0[bj][e] * up + w1[bj][e] * cur + w2[bj][e] * dn + bb[bj][e]; }
                    float o[4];
#pragma unroll
                    for (int e = 0; e < 4; ++e) o[e] = cv[0][e] * sigmoidf_(cv[0][e]) * cv[1][e];
                    const int i = ai * 128 + wr * 64 + m * 16 + fr;
                    if (i >= lo && i <= hi) { u32x2 w; w.x = cvtpk(o[0], o[1]); w.y = cvtpk(o[2], o[3]); *(u32x2*)(ACT + (size_t)(row0 + i) * DFF + cgc) = w; }
                }
            }
        }
    }
};
}

namespace att {
constexpr int QBLK = 32, KVBLK = 64;
constexpr int SHM_V = KVBLK * 64 * 2, SHM_K = KVBLK * 256;
constexpr float THR2 = 8.0f;
#define KSWZ(row, colB) ((row) * 256 + ((colB) ^ (((row) & 15) << 4)))
#define SBAR() __builtin_amdgcn_sched_barrier(0)
DI int crow(int r, int hi) { return (r & 3) + 8 * (r >> 2) + 4 * hi; }
DI unsigned cvtpk_a(float lo, float hi) { unsigned r; asm volatile("v_cvt_pk_bf16_f32 %0, %1, %2" : "=v"(r) : "v"(lo), "v"(hi)); return r; }
DI void partialSM(f32x16& p0, f32x16& p1, float& m_reg, float& mn, float& alpha) {
    float pmax = p0[0];
#pragma unroll
    for (int r = 1; r < 16; ++r) pmax = fmaxf(pmax, p0[r]);
#pragma unroll
    for (int r = 0; r < 16; ++r) pmax = fmaxf(pmax, p1[r]);
    { auto rr = __builtin_amdgcn_permlane32_swap(__float_as_uint(pmax), __float_as_uint(pmax), false, false); pmax = fmaxf(__uint_as_float(rr[0]), __uint_as_float(rr[1])); }
    if (__builtin_expect(__all(pmax - m_reg <= THR2), 1)) { mn = m_reg; alpha = 1.f; }
    else { mn = fmaxf(m_reg, pmax); alpha = __builtin_amdgcn_exp2f(m_reg - mn); m_reg = mn; }
    { f32x2 nm = {-mn, -mn}; asm volatile("" : "+v"(nm));
#pragma unroll
      for (int r = 0; r < 8; ++r) { f32x2 a = {p0[2 * r], p0[2 * r + 1]}, b = {p1[2 * r], p1[2 * r + 1]}; a = a + nm; b = b + nm; p0[2 * r] = a[0]; p0[2 * r + 1] = a[1]; p1[2 * r] = b[0]; p1[2 * r + 1] = b[1]; } }
#pragma unroll
    for (int r = 0; r < 16; ++r) p0[r] = __builtin_amdgcn_exp2f(p0[r]);
}
DI void finishSM(f32x16& p0, f32x16& p1, float alpha, float& l_reg, bf16x8& pa0, bf16x8& pa1, bf16x8& pa2, bf16x8& pa3) {
#pragma unroll
    for (int r = 0; r < 16; ++r) p1[r] = __builtin_amdgcn_exp2f(p1[r]);
    typedef float f32x8_ __attribute__((ext_vector_type(8)));
    const f32x16 t16 = p0 + p1;
    const f32x8_ t8 = __builtin_shufflevector(t16, t16, 0, 1, 2, 3, 4, 5, 6, 7) + __builtin_shufflevector(t16, t16, 8, 9, 10, 11, 12, 13, 14, 15);
    const f32x4 t4 = __builtin_shufflevector(t8, t8, 0, 1, 2, 3) + __builtin_shufflevector(t8, t8, 4, 5, 6, 7);
    const f32x2 t2 = __builtin_shufflevector(t4, t4, 0, 1) + __builtin_shufflevector(t4, t4, 2, 3);
    float ps = t2[0] + t2[1];
    { auto rr = __builtin_amdgcn_permlane32_swap(__float_as_uint(ps), __float_as_uint(ps), false, false); ps = __uint_as_float(rr[0]) + __uint_as_float(rr[1]); }
    l_reg = l_reg * alpha + ps;
#define PK4(P, BASE, OUT) do { unsigned a0 = cvtpk_a(P[BASE + 0], P[BASE + 1]), a1 = cvtpk_a(P[BASE + 2], P[BASE + 3]);   \
    unsigned b0 = cvtpk_a(P[BASE + 4], P[BASE + 5]), b1 = cvtpk_a(P[BASE + 6], P[BASE + 7]);                              \
    auto r0 = __builtin_amdgcn_permlane32_swap(a0, b0, false, false); auto r1 = __builtin_amdgcn_permlane32_swap(a1, b1, false, false); \
    u32x4 w = {r0[0], r1[0], r0[1], r1[1]}; OUT = *reinterpret_cast<bf16x8*>(&w); } while (0)
    PK4(p0, 0, pa0); PK4(p0, 8, pa1); PK4(p1, 0, pa2); PK4(p1, 8, pa3);
#undef PK4
}
DI void qkt(f32x16& p0, f32x16& p1, const char* Ks, const bf16x8* qr, int r32, int hi) {
    p0 = f32x16{}; p1 = f32x16{};
#pragma unroll
    for (int d0 = 0; d0 < 6; ++d0) { const int cb = (d0 * 16 + hi * 8) * 2;
        const bf16x8 b0 = *reinterpret_cast<const bf16x8*>(Ks + KSWZ(r32, cb));
        const bf16x8 b1 = *reinterpret_cast<const bf16x8*>(Ks + KSWZ(32 + r32, cb));
        p0 = __builtin_amdgcn_mfma_f32_32x32x16_bf16(b0, qr[d0], p0, 0, 0, 0);
        p1 = __builtin_amdgcn_mfma_f32_32x32x16_bf16(b1, qr[d0], p1, 0, 0, 0); }
}
DI int v_st(int k, int c) { const int kk = (k & ~0xC) | ((k & 4) << 1) | ((k & 8) >> 1); return ((kk >> 3) * 2 + (c >> 5)) * 512 + ((kk & 7) * 32 + (c & 31)) * 2; }
DI int v_rd_base(int lane) { return ((lane & 3) << 3) | (((lane >> 2) & 3) << 6) | (((lane >> 4) & 1) << 5) | (((lane >> 5) & 1) << 8); }
constexpr int v_rd_off(int d0, int ks, int half) { return d0 * 512 + ks * 2048 + half * 1024; }
template <int OFF> DI s16x4 tr_read(int vb) { s16x4 r; asm volatile("ds_read_b64_tr_b16 %0, %1 offset:%2" : "=&v"(r) : "v"(vb), "i"(OFF) : "memory"); return r; }
template <int D0> DI void pv_one(f32x16& od, int vb, bf16x8 pa0, bf16x8 pa1, bf16x8 pa2, bf16x8 pa3) {
    const s16x4 l0 = tr_read<v_rd_off(D0, 0, 0)>(vb), h0 = tr_read<v_rd_off(D0, 0, 1)>(vb), l1 = tr_read<v_rd_off(D0, 1, 0)>(vb), h1 = tr_read<v_rd_off(D0, 1, 1)>(vb);
    const s16x4 l2 = tr_read<v_rd_off(D0, 2, 0)>(vb), h2 = tr_read<v_rd_off(D0, 2, 1)>(vb), l3 = tr_read<v_rd_off(D0, 3, 0)>(vb), h3 = tr_read<v_rd_off(D0, 3, 1)>(vb);
    asm volatile("s_waitcnt lgkmcnt(0)" ::: "memory"); SBAR();
#define PK(L, H) (bf16x8){L[0], L[1], L[2], L[3], H[0], H[1], H[2], H[3]}
    od = __builtin_amdgcn_mfma_f32_32x32x16_bf16(pa0, PK(l0, h0), od, 0, 0, 0);
    od = __builtin_amdgcn_mfma_f32_32x32x16_bf16(pa1, PK(l1, h1), od, 0, 0, 0);
    od = __builtin_amdgcn_mfma_f32_32x32x16_bf16(pa2, PK(l2, h2), od, 0, 0, 0);
    od = __builtin_amdgcn_mfma_f32_32x32x16_bf16(pa3, PK(l3, h3), od, 0, 0, 0);
#undef PK
}
DI void pv_d0(f32x16* o, int vb, bf16x8 pa0, bf16x8 pa1, bf16x8 pa2, bf16x8 pa3) { pv_one<0>(o[0], vb, pa0, pa1, pa2, pa3); pv_one<1>(o[1], vb, pa0, pa1, pa2, pa3); }

DI void attn_unit(const bf16_t* __restrict__ Qb, const bf16_t* __restrict__ Knh, const bf16_t* __restrict__ KRs, const bf16_t* __restrict__ Vh, bf16_t* __restrict__ Ob, int seq, char* lds) {
    int tid_ = threadIdx.x; asm volatile("" : "+v"(tid_));
    const int tid = tid_, wid = tid >> 6, lane = tid & 63, r32 = lane & 31, hi = lane >> 5;
    char* V_lds = lds; char* K_lds = lds + 3 * SHM_V;
    float* ws = (float*)(lds + 3 * SHM_V + 3 * SHM_K) + wid * 64; float* li_l = ws; float* al_l = ws + 32;
    float m_reg = -1e30f, l_reg = 0; f32x16 o[2] = {}; bf16x8 qr[6];
    const bf16_t* Qw = Qb + (long)(wid * QBLK + r32) * 768 + hi * 8;
#pragma unroll
    for (int d0 = 0; d0 < 6; ++d0) qr[d0] = *reinterpret_cast<const bf16x8*>(Qw + d0 * 16);
    const int sr = tid >> 3, sc = (tid & 7) * 8, vst = v_st(sr, sc), kst = KSWZ(sr, sc * 2);
    const int rrw = (tid & 255) >> 2, rcl = (tid & 3) * 8, krst = KSWZ(rrw, 128 + rcl * 2);
    const bool rwr = tid < 256;
    const int vb0 = (int)(uintptr_t)V_lds + v_rd_base(lane);
    struct { bf16x8 vs, ks, rs; } sr_[1];
#define SLOAD(i, k0) do { sr_[i].vs = *reinterpret_cast<const bf16x8*>(&Vh[(long)((k0) + sr) * 512 + sc]); sr_[i].ks = *reinterpret_cast<const bf16x8*>(&Knh[(long)((k0) + sr) * 512 + sc]); \
    sr_[i].rs = *reinterpret_cast<const bf16x8*>(&KRs[(long)((k0) + rrw) * 32 + rcl]); } while (0)
#define SWRITE(b, i) do { *(bf16x8*)(V_lds + (b) * SHM_V + vst) = sr_[i].vs; *(bf16x8*)(K_lds + (b) * SHM_K + kst) = sr_[i].ks; if (rwr) *(bf16x8*)(K_lds + (b) * SHM_K + krst) = sr_[i].rs; } while (0)
#define SWAIT() asm volatile("s_waitcnt vmcnt(0)" ::: "memory")
#define RESC(a) do { if (__any((a) < 1.f)) { if (hi == 0) al_l[r32] = (a); asm volatile("s_waitcnt lgkmcnt(0)" ::: "memory"); \
    _Pragma("unroll") for (int d = 0; d < 2; ++d) _Pragma("unroll") for (int r = 0; r < 16; ++r) o[d][r] *= al_l[crow(r, hi)]; } } while (0)
    f32x16 pA0, pA1, pB0, pB1; float mnA, mnB, alA, alB; bf16x8 pa0, pa1, pa2, pa3; const int NT = seq / KVBLK;
    int b_prev = 2, b_cur = 0, b_next = 1;
#define ROT3() do { b_prev = b_cur; b_cur = b_next; b_next = (b_next == 2) ? 0 : b_next + 1; } while (0)
#define STEP(PX0, PX1, mnX, alX, PY0, PY1, alY, jj) do { ROT3(); __syncthreads(); \
        SLOAD(0, ((jj) + 1 < NT ? (jj) + 1 : NT - 1) * KVBLK); \
        SBAR(); qkt(PX0, PX1, K_lds + b_cur * SHM_K, qr, r32, hi); \
        finishSM(PY0, PY1, alY, l_reg, pa0, pa1, pa2, pa3); SBAR(); \
        pv_d0(o, vb0 + b_prev * SHM_V, pa0, pa1, pa2, pa3); partialSM(PX0, PX1, m_reg, mnX, alX); \
        RESC(alX); SWAIT(); SWRITE(b_next, 0); } while (0)
    SLOAD(0, 0); asm volatile("s_waitcnt vmcnt(0)" ::: "memory"); SWRITE(0, 0); __syncthreads();
    SLOAD(0, KVBLK);
    qkt(pA0, pA1, K_lds, qr, r32, hi); partialSM(pA0, pA1, m_reg, mnA, alA);
    SWAIT(); SWRITE(1, 0);
    for (int j = 1; j + 1 < NT; j += 2) {
        STEP(pB0, pB1, mnB, alB, pA0, pA1, alA, j);
        STEP(pA0, pA1, mnA, alA, pB0, pB1, alB, j + 1);
    }
    STEP(pB0, pB1, mnB, alB, pA0, pA1, alA, NT - 1);
    finishSM(pB0, pB1, alB, l_reg, pa0, pa1, pa2, pa3); SBAR();
    pv_d0(o, vb0 + b_cur * SHM_V, pa0, pa1, pa2, pa3);
    if (hi == 0) li_l[r32] = l_reg; asm volatile("s_waitcnt lgkmcnt(0)" ::: "memory");
    float rli[16];
#pragma unroll
    for (int r = 0; r < 16; ++r) rli[r] = __builtin_amdgcn_rcpf(li_l[crow(r, hi)]);
    bf16_t* Ow = Ob + (long)(wid * QBLK) * 512;
#pragma unroll
    for (int r = 0; r < 16; ++r) { const int orow = crow(r, hi);
#pragma unroll
        for (int d0 = 0; d0 < 2; ++d0) Ow[(long)orow * 512 + d0 * 32 + r32] = (bf16_t)(cvtpk(o[d0][r] * rli[r], 0.f) & 0xffffu); }
    __syncthreads();
#undef SLOAD
#undef SWRITE
#undef SWAIT
#undef RESC
#undef STEP
#undef ROT3
}
}

#define XB_TMO      128
#define XB_XCNT(j)  (256  + 64 * (j))
#define XB_XSUB(j)  (1280 + 64 * (j))
#define XB_XGEN(j)  (2304 + 64 * (j))
#define XB_TOP      3328
#define XB_TOPGEN   3392
#define XCD_BAR_WORDS 3456
#define XB_SPIN_CAP (1u << 18)

__device__ __forceinline__ unsigned xb_ld(unsigned* p)              { return __hip_atomic_load(p, __ATOMIC_RELAXED, __HIP_MEMORY_SCOPE_AGENT); }
__device__ __forceinline__ unsigned xb_add(unsigned* p, unsigned v) { return __hip_atomic_fetch_add(p, v, __ATOMIC_RELAXED, __HIP_MEMORY_SCOPE_AGENT); }
__device__ __forceinline__ unsigned xb_xcc_id() { return (unsigned)__builtin_amdgcn_s_getreg((3 << 11) | 20) & 0xFu; }
#define XB_SPIN(cond, bar) do { unsigned _sp = 0; while (cond) { __builtin_amdgcn_s_sleep(1); \
    if ((++_sp & 255u) == 0u) { if (xb_ld(&(bar)[XB_TMO])) break; if (_sp > XB_SPIN_CAP) { atomicAdd(&(bar)[XB_TMO], 1u); break; } } } } while (0)

struct XcdBarrier {
    unsigned* bar; unsigned x;
    volatile LAS unsigned* st;
};

__device__ __forceinline__ XcdBarrier xcd_barrier_post(unsigned* bar, volatile LAS unsigned* st) {
    XcdBarrier b; b.bar = bar; b.x = xb_xcc_id(); b.st = st;
    if (threadIdx.x == 0) (void)xb_add(&bar[XB_XCNT(b.x)], 1u);
    return b;
}
__device__ __forceinline__ void xcd_barrier_complete(unsigned* bar, unsigned x, unsigned& nloc, unsigned& nx) {
    const unsigned G = gridDim.x * gridDim.y * gridDim.z;
    unsigned sum, cnt, mine, sp = 0u;
    for (;;) {
        sum = 0u; cnt = 0u; mine = 0u;
#pragma unroll
        for (unsigned j = 0; j < 16; ++j) { const unsigned c = xb_ld(&bar[XB_XCNT(j)]); sum += c; cnt += (c > 0u) ? 1u : 0u; mine = (j == x) ? c : mine; }
        if (sum == G) break;
        __builtin_amdgcn_s_sleep(1);
        if ((++sp & 255u) == 0u) { if (xb_ld(&bar[XB_TMO])) break; if (sp > XB_SPIN_CAP) { atomicAdd(&bar[XB_TMO], 1u); break; } }
    }
    nloc = mine > 0u ? mine : 1u; nx = cnt > 0u ? cnt : 1u;
}

__device__ __forceinline__ void xcd_barrier(const XcdBarrier& b) {
    asm volatile("s_waitcnt vmcnt(0)" ::: "memory");
    __syncthreads();
    if (threadIdx.x == 0) {
        unsigned* bar = b.bar;
        __builtin_amdgcn_s_waitcnt(0);
        unsigned nloc = b.st[0], nx = b.st[1];
        if (nloc == 0u) { xcd_barrier_complete(bar, b.x, nloc, nx); b.st[0] = nloc; b.st[1] = nx; }
        const unsigned old = xb_add(&bar[XB_XSUB(b.x)], 1u);
        const unsigned gen = old / nloc;
        if (old + 1u == (gen + 1u) * nloc) {
            __builtin_amdgcn_fence(__ATOMIC_RELEASE, "agent");
            asm volatile("s_waitcnt vmcnt(0)" ::: "memory");
            const unsigned og = xb_add(&bar[XB_TOP], 1u);
            const unsigned tg = og / nx;
            if (og + 1u == (tg + 1u) * nx) xb_add(&bar[XB_TOPGEN], 1u);
            else XB_SPIN(xb_ld(&bar[XB_TOPGEN]) == tg, bar);
            __builtin_amdgcn_fence(__ATOMIC_ACQUIRE, "agent");
            xb_add(&bar[XB_XGEN(b.x)], 1u);
            asm volatile("s_waitcnt vmcnt(0)" ::: "memory");
        } else {
            XB_SPIN(xb_ld(&bar[XB_XGEN(b.x)]) == gen, bar);
            __builtin_amdgcn_fence(__ATOMIC_ACQUIRE, "agent");
            asm volatile("s_waitcnt vmcnt(0)" ::: "memory");
        }
    }
    __syncthreads();
}


DI int srccol(int id, int n) {
    switch (id) {
        case 0: return n < 384 ? n : (n < 416 ? 384 + ((n - 384) >> 1) + 16 * ((n - 384) & 1) : -1);
        case 1: return 928 + n;
        case 2: return 1952 + n;
        case 3: { const int h = n / 96, d = n - 96 * h; return d < 64 ? h * 96 + d : h * 96 + 64 + ((d - 64) >> 1) + 16 * ((d - 64) & 1); }
        case 4: return n < 512 ? (n >> 6) * 128 + (n & 63) : ((n - 512) >> 6) * 128 + 64 + (n & 63);
        case 6: { const int pn = n >> 8, lo = n & 255; return (lo >> 7) * DFF + pn * 128 + (lo & 127); }
        default: return n;
    }
}
DI void transpose_item(const float* W, int ldw, int K, int N, bf16_t* WT, int id, const float* ks, float cs, LAS float* scr, int item, int lane) {
    const int nblk = N / 32, kb = item / nblk, nb = item - kb * nblk, k0 = 64 * kb, n0 = 32 * nb;
    const int sc = srccol(id, n0 + (lane & 31));
#pragma unroll 8
    for (int i = 0; i < 32; ++i) { const int kk = 2 * i + (lane >> 5); const float g = ks ? ks[k0 + kk] * cs : cs;
        scr[kk * 33 + (lane & 31)] = sc >= 0 ? W[(size_t)(k0 + kk) * ldw + sc] * g : 0.f; }
    asm volatile("s_waitcnt lgkmcnt(0)" ::: "memory");
    const int c = lane & 7;
#pragma unroll
    for (int j = 0; j < 4; ++j) { const int n = (lane >> 3) + 8 * j; const LAS float* s = scr + (8 * c) * 33 + n;
        u32x4 o; o.x = cvtpk(s[0 * 33], s[1 * 33]); o.y = cvtpk(s[2 * 33], s[3 * 33]); o.z = cvtpk(s[4 * 33], s[5 * 33]); o.w = cvtpk(s[6 * 33], s[7 * 33]);
        *(u32x4*)(WT + (size_t)(n0 + n) * K + k0 + 8 * c) = o; }
    asm volatile("s_waitcnt lgkmcnt(0)" ::: "memory");
}

#define GRID_SYNC() do { asm volatile("s_waitcnt vmcnt(0) lgkmcnt(0)" ::: "memory"); grid.sync(); __builtin_amdgcn_fence(__ATOMIC_ACQUIRE, "agent"); asm volatile("s_waitcnt vmcnt(0)" ::: "memory"); __syncthreads(); } while (0)
#define XCD_SYNC() xcd_barrier(xbar)
struct Args { const float* in[17]; float* out; unsigned char* ws; };

__global__ void __launch_bounds__(512, 2) mega_fwd(Args a) {
    extern __shared__ __attribute__((aligned(16))) unsigned char lds_raw[];
    cg::grid_group grid = cg::this_grid();
    LAS unsigned char* lds = (LAS unsigned char*)lds_raw;
    if (threadIdx.x < 4) ((volatile LAS unsigned*)(lds + MISC_OFF))[threadIdx.x] = 0u;
    __syncthreads();
    const int G = gridDim.x, bx = blockIdx.x;
    const int vcu = (G % 8 == 0) ? (bx % 8) * (G / 8) + bx / 8 : bx;
    unsigned char* ws = a.ws;
    const float *xp = a.in[0], *xs = a.in[1], *g_mix = a.in[2], *w_in = a.in[3], *g_q = a.in[4], *w_uq = a.in[5], *g_kv = a.in[6], *w_ukv = a.in[7], *w_ao = a.in[8], *w_fo = a.in[9],
                *w_out = a.in[10], *g_ffn = a.in[11], *w_up = a.in[12], *conv_w = a.in[13], *conv_b = a.in[14], *w_down = a.in[15], *g_final = a.in[16];
    float* out = a.out;
    float *r1 = (float*)(ws + WS_R1), *ssqq = (float*)(ws + WS_SSQQ), *ssqkv = (float*)(ws + WS_SSQKV), *ssq2 = (float*)(ws + WS_SSQ2), *ssq3 = (float*)(ws + WS_SSQ3);
    float *ropec = (float*)(ws + WS_ROPEC), *ropes = (float*)(ws + WS_ROPES);
    bf16_t *WinT = (bf16_t*)(ws + WS_WIN), *WgaT = (bf16_t*)(ws + WS_WGA), *WgfT = (bf16_t*)(ws + WS_WGF), *WuqT = (bf16_t*)(ws + WS_WUQ), *WukvT = (bf16_t*)(ws + WS_WUKV),
           *WaoT = (bf16_t*)(ws + WS_WAO), *WfoT = (bf16_t*)(ws + WS_WFO), *WoT = (bf16_t*)(ws + WS_WO), *WxfT = (bf16_t*)(ws + WS_WXF), *WupT = (bf16_t*)(ws + WS_WUP), *WdT = (bf16_t*)(ws + WS_WD),
           *DFTm = (bf16_t*)(ws + WS_DFT);
    bf16_t *XB = (bf16_t*)(ws + WS_XB), *CQ = (bf16_t*)(ws + WS_CQ), *CKV = (bf16_t*)(ws + WS_CKV), *KR = (bf16_t*)(ws + WS_KR), *Qb = (bf16_t*)(ws + WS_Q), *KN = (bf16_t*)(ws + WS_KN),
           *Vb = (bf16_t*)(ws + WS_V), *Fb = (bf16_t*)(ws + WS_F), *AO = (bf16_t*)(ws + WS_AO), *MIX = (bf16_t*)(ws + WS_MIX), *TMPB = (bf16_t*)(ws + WS_TMP), *ACT = (bf16_t*)(ws + WS_ACT);
    bf16_t *XP = (bf16_t*)((unsigned char*)out + OUT_XP), *P2 = (bf16_t*)((unsigned char*)out + OUT_P2);
    const int NGW = G * NWAVES, GT = G * 512;
    using pg8::Op; using pg8::StaticOrder;

    {
        int tid_ = threadIdx.x; asm volatile("" : "+v"(tid_));
        const int tid = tid_, lane = tid & 63, wave = __builtin_amdgcn_readfirstlane(tid >> 6), gw = vcu * NWAVES + wave, gtid = bx * 512 + tid;
        for (int row = gw; row < T; row += 2 * NGW) {
            const int row2 = row + NGW; const bool has2 = row2 < T; const int rb = has2 ? row2 : row;
            const float* xr = row < TP ? xp + (size_t)row * 1024 : xs + (size_t)(row - TP) * 1024;
            const float* xq = rb < TP ? xp + (size_t)rb * 1024 : xs + (size_t)(rb - TP) * 1024;
            f32x4 v[4], w[4]; float s = 0.f, s2 = 0.f;
#pragma unroll
            for (int j = 0; j < 4; ++j) { v[j] = ((const f32x4*)xr)[lane + 64 * j]; w[j] = ((const f32x4*)xq)[lane + 64 * j]; }
#pragma unroll
            for (int j = 0; j < 4; ++j) { s += pg8::dot4(v[j]); s2 += pg8::dot4(w[j]); }
            s = wave_sum(s); s2 = wave_sum(s2);
            if (lane == 0) { r1[row] = __builtin_amdgcn_rsqf(s * (1.0f / 1024.0f) + EPS); if (has2) r1[row2] = __builtin_amdgcn_rsqf(s2 * (1.0f / 1024.0f) + EPS); }
            u32x2* o8 = (u32x2*)(XB + (size_t)row * 1024) + lane; u32x2* o9 = (u32x2*)(XB + (size_t)rb * 1024) + lane;
#pragma unroll
            for (int j = 0; j < 4; ++j) { u32x2 a; a.x = cvtpk(v[j][0], v[j][1]); a.y = cvtpk(v[j][2], v[j][3]); o8[64 * j] = a; }
            if (has2) {
#pragma unroll
                for (int j = 0; j < 4; ++j) { u32x2 a; a.x = cvtpk(w[j][0], w[j][1]); a.y = cvtpk(w[j][2], w[j][3]); o9[64 * j] = a; } }
        }
        LAS float* scr = (LAS float*)(lds + wave * 8448);
        constexpr int I0 = 16 * 16, I1 = 16 * 32, I3 = 4 * 24, I4 = 2 * 32, I5 = 8 * 32, I7 = 16 * 32, I8 = 16 * 176, I9 = 44 * 32;
        constexpr int NIT = I0 + 2 * I1 + I3 + I4 + 2 * I5 + I7 + I8 + I9;
        const float qscale = 0.10206207261596577f * LOG2E;
        for (int it = gw; it < NIT; it += NGW) {
            int r = it;
            if (r < I0) { transpose_item(w_in, INC, 1024, 512, WinT, 0, g_mix, 1.f, scr, r, lane); continue; } r -= I0;
            if (r < I1) { transpose_item(w_in, INC, 1024, 1024, WgaT, 1, g_mix, 1.f, scr, r, lane); continue; } r -= I1;
            if (r < I1) { transpose_item(w_in, INC, 1024, 1024, WgfT, 2, g_mix, 1.f, scr, r, lane); continue; } r -= I1;
            if (r < I3) { transpose_item(w_uq, 768, 256, 768, WuqT, 3, g_q, qscale, scr, r, lane); continue; } r -= I3;
            if (r < I4) { transpose_item(w_ukv, 1024, 128, 1024, WukvT, 4, g_kv, 1.f, scr, r, lane); continue; } r -= I4;
            if (r < I5) { transpose_item(w_ao, 1024, 512, 1024, WaoT, 5, nullptr, 1.f, scr, r, lane); continue; } r -= I5;
            if (r < I5) { transpose_item(w_fo, 1024, 512, 1024, WfoT, 5, nullptr, 1.f, scr, r, lane); continue; } r -= I5;
            if (r < I7) { transpose_item(w_out, 1024, 1024, 1024, WoT, 5, nullptr, 1.f, scr, r, lane); continue; } r -= I7;
            if (r < I8) { transpose_item(w_up, 2 * DFF, 1024, 2 * DFF, WupT, 6, g_ffn, 1.f, scr, r, lane); continue; } r -= I8;
            transpose_item(w_down, 1024, DFF, 1024, WdT, 5, nullptr, 1.f, scr, r, lane);
        }
        for (int i = gtid; i < 4 * 65536; i += GT) {
            const int mat = i >> 16, rr = (i >> 8) & 255, kk = i & 255; float val = 0.f;
            if (mat == 0) { const int co = rr >> 7, k1 = rr & 127, ci = kk >> 7, n1 = kk & 127; const float rev = (float)((n1 * k1) & 127) * (1.0f / 128.0f);
                const float cs = cos_rev(rev), sn = sin_rev(rev); val = (co == ci ? cs : (co == 0 ? sn : -sn)) * 0.08838834764831845f; }
            else if (mat == 1) { const int co = rr >> 7, h = (rr >> 6) & 1, k1 = rr & 63, h2 = kk >> 7, ci = (kk >> 6) & 1, n1 = kk & 63; const float rev = (float)((n1 * k1) & 63) * (1.0f / 64.0f);
                const float cs = cos_rev(rev), sn = sin_rev(rev); val = (h == h2) ? (co == ci ? cs : (co == 0 ? sn : -sn)) * 0.125f : 0.f; }
            else if (mat == 2) { if (rr < 128) { const int k2 = rr, c = kk >> 7, n2 = kk & 127; const float rev = (float)((n2 * k2) & 127) * (1.0f / 128.0f); val = (c == 0 ? cos_rev(rev) : sin_rev(rev)) * 0.08838834764831845f; } }
            else { if (rr < 128) { const int h = rr >> 6, k2 = rr & 63, h2 = kk >> 7, c = (kk >> 6) & 1, n2 = kk & 63; const float rev = (float)((n2 * k2) & 63) * (1.0f / 64.0f);
                val = (h == h2) ? (c == 0 ? cos_rev(rev) : sin_rev(rev)) * 0.125f : 0.f; } }
            DFTm[i] = (bf16_t)(cvtpk(val, 0.f) & 0xffffu);
        }
        for (int i = gtid; i < 16384 * 16; i += GT) {
            const int pos = i >> 4, k = i & 15;
            const double q4[4] = {1.0, 0.5623413251903491, 0.31622776601683794, 0.1778279410038923};
            double invf = (k & 3) == 0 ? q4[0] : ((k & 3) == 1 ? q4[1] : ((k & 3) == 2 ? q4[2] : q4[3]));
            invf = (k >> 2) == 0 ? invf : ((k >> 2) == 1 ? invf * 0.1 : ((k >> 2) == 2 ? invf * 0.01 : invf * 0.001));
            double rev = (double)pos * invf * 0.15915494309189535; rev = rev - (double)(long long)rev;
            ropec[i] = cos_rev((float)rev); ropes[i] = sin_rev((float)rev);
        }
        for (int i = gtid; i < T; i += GT) { ssqq[i] = 0.f; ssqkv[i] = 0.f; ssq2[i] = 0.f; ssq3[i] = 0.f; }
        for (int i = gtid; i < 384 * 16; i += GT) ((unsigned*)(ws + WS_PCNT))[i] = 0u;
        for (int i = gtid; i < XCD_BAR_WORDS; i += GT) ((unsigned*)(ws + WS_BAR))[i] = 0u;
        __syncthreads();
        for (int it = bx; it < 256; it += G) {
            const int pm = it >> 6, k0 = (it & 63) * 16;
            LAS float* tile = (LAS float*)lds; LAS float* ct = tile + 16 * 129; LAS float* st = ct + 128;
            for (int i = tid; i < 16 * 128; i += 512) { const int kk = i >> 7, cc = i & 127; tile[kk * 129 + cc] = w_in[(size_t)(k0 + kk) * INC + 416 + pm * 128 + cc]; }
            if (tid < 128) { const float rev = (float)tid * (1.0f / 128.0f); ct[tid] = cos_rev(rev); st[tid] = sin_rev(rev); }
            __syncthreads();
            const int kk = tid & 15, wg = tid >> 4; const float gsc = g_mix[k0 + kk] * 0.08838834764831845f;
            for (int wl = wg * 8; wl < wg * 8 + 8; ++wl) {
                const int c = wl >> 7, cp = wl & 127; float s = 0.f;
                for (int cc = 0; cc < 128; ++cc) { const float tv = c == 0 ? ct[(cc * cp) & 127] : st[(cc * cp) & 127]; s += tile[kk * 129 + cc] * tv; }
                if (c == 1) s = -s;
                WxfT[(size_t)(pm * 256 + wl) * 1024 + k0 + kk] = (bf16_t)(cvtpk(s * gsc, 0.f) & 0xffffu);
            }
            __syncthreads();
        }
    }
    GRID_SYNC();
    const XcdBarrier xbar = xcd_barrier_post((unsigned*)(ws + WS_BAR), (volatile LAS unsigned*)(lds + MISC_OFF));

    {
        { Op<0> A{(const char*)XB, 256 * 2048, 2048, 128 * 2048}; Op<0> B{(const char*)WinT, 256 * 2048, 2048, 128 * 2048};
          StaticOrder S; S.init(384, 2, G, bx); pg8::EpiInproj E{r1, CQ, CKV, KR, ssqq, ssqkv, ropec, ropes};
          pg8::gemm_phase(lds, A, B, 1024, S, E); }
        { Op<0> A{(const char*)WxfT, 256 * 2048, 2048, 128 * 2048}; Op<1> B{(const char*)XB, 0, 128 * 2048, 2048};
          StaticOrder S; S.init(4, 128, G, bx); pg8::EpiF1<0> E{r1, XP};
          pg8::gemm_phase(lds, A, B, 1024, S, E); }
        { Op<0> A{(const char*)WxfT, 256 * 2048, 2048, 128 * 2048}; Op<2> B{(const char*)(XB + (size_t)TP * 1024), 0, 0, 32 * 2048};
          StaticOrder S; S.init(4, 256, G, bx); pg8::EpiF1<1> E{r1, XP + (size_t)TP * 1024};
          pg8::gemm_phase(lds, A, B, 1024, S, E); }
    }
    XCD_SYNC();

    {
        { Op<0> A{(const char*)CQ, 256 * 512, 512, 128 * 512}; Op<0> B{(const char*)WuqT, 256 * 512, 512, 128 * 512};
          StaticOrder S; S.init(384, 3, G, bx); pg8::EpiQup E{ssqq, Qb, ropec, ropes};
          pg8::gemm_phase(lds, A, B, 256, S, E); }
        { Op<0> A{(const char*)CKV, 256 * 256, 256, 128 * 256}; Op<0> B{(const char*)WukvT, 256 * 256, 256, 128 * 256};
          StaticOrder S; S.init(384, 4, G, bx); pg8::EpiKVup E{ssqkv, KN, Vb};
          pg8::gemm_phase(lds, A, B, 128, S, E); }
        { Op<0> A{(const char*)DFTm, 0, 512, 128 * 512}; Op<0> B{(const char*)XP, 256 * 512, 512, 128 * 512};
          StaticOrder S; S.init(1, 512, G, bx); pg8::EpiF2<0> E{P2};
          pg8::gemm_phase(lds, A, B, 256, S, E); }
        { Op<0> A{(const char*)(DFTm + 65536), 0, 512, 128 * 512}; Op<0> B{(const char*)(XP + (size_t)TP * 1024), 256 * 512, 512, 128 * 512};
          StaticOrder S; S.init(1, 1024, G, bx); pg8::EpiF2<1> E{P2 + (size_t)TP * 1024};
          pg8::gemm_phase(lds, A, B, 256, S, E); }
    }
    XCD_SYNC();

    {
        { Op<0> A{(const char*)(DFTm + 2 * 65536), 0, 512, 128 * 512}; Op<4> B{(const char*)P2, 256 * 256, 131072, (size_t)128 * 131072};
          StaticOrder S; S.init(1, 512, G, bx); pg8::EpiF3<0> E{Fb};
          pg8::gemm_phase(lds, A, B, 256, S, E); }
        { Op<0> A{(const char*)(DFTm + 3 * 65536), 0, 512, 128 * 512}; Op<4> B{(const char*)(P2 + (size_t)TP * 1024), 256 * 512, 262144, (size_t)128 * 262144};
          StaticOrder S; S.init(1, 1024, G, bx); pg8::EpiF3<1> E{Fb};
          pg8::gemm_phase(lds, A, B, 256, S, E); }
        __syncthreads();
        if (G == 256) {
            for (int i = 0; i < 12; ++i) {
                int base, S, h, qb;
                if (i < 4) { const int p = 2 * (vcu >> 5) + (i >> 1); base = (p >> 3) * 16384; h = p & 7; S = 16384; qb = (vcu & 31) + 32 * (i & 1); }
                else { const int p = (vcu >> 4) * 8 + (i - 4); base = TP + (p >> 3) * 4096; h = p & 7; S = 4096; qb = vcu & 15; }
                att::attn_unit(Qb + (size_t)(base + qb * 256) * 768 + h * 96, KN + (size_t)base * 512 + h * 64, KR + (size_t)base * 32, Vb + (size_t)base * 512 + h * 64,
                               AO + (size_t)(base + qb * 256) * 512 + h * 64, S, (char*)lds_raw);
            }
        } else {
            for (int uidx = bx; uidx < 3072; uidx += G) {
                int base, S, h, qb;
                if (uidx < 1024) { const int p = uidx >> 6; base = (p >> 3) * 16384; h = p & 7; S = 16384; qb = uidx & 63; }
                else { const int v = uidx - 1024, p = v >> 4; base = TP + (p >> 3) * 4096; h = p & 7; S = 4096; qb = v & 15; }
                att::attn_unit(Qb + (size_t)(base + qb * 256) * 768 + h * 96, KN + (size_t)base * 512 + h * 64, KR + (size_t)base * 32, Vb + (size_t)base * 512 + h * 64,
                               AO + (size_t)(base + qb * 256) * 512 + h * 64, S, (char*)lds_raw);
            }
        }
    }
    XCD_SYNC();

    {
        StaticOrder S; S.init(384, 4, G, bx);
        { Op<0> A{(const char*)XB, 256 * 2048, 2048, 128 * 2048}; Op<0> B{(const char*)WgaT, 256 * 2048, 2048, 128 * 2048}; pg8::EpiGate E{r1, MIX}; pg8::gemm_phase(lds, A, B, 1024, S, E); }
        { Op<0> A{(const char*)AO, 256 * 1024, 1024, 128 * 1024}; Op<0> B{(const char*)WaoT, 256 * 1024, 1024, 128 * 1024}; pg8::EpiMix<false> E{MIX, TMPB}; pg8::gemm_phase(lds, A, B, 512, S, E); }
        { Op<0> A{(const char*)XB, 256 * 2048, 2048, 128 * 2048}; Op<0> B{(const char*)WgfT, 256 * 2048, 2048, 128 * 2048}; pg8::EpiGate E{r1, TMPB}; pg8::gemm_phase(lds, A, B, 1024, S, E); }
        { Op<0> A{(const char*)Fb, 256 * 1024, 1024, 128 * 1024}; Op<0> B{(const char*)WfoT, 256 * 1024, 1024, 128 * 1024}; pg8::EpiMix<true> E{MIX, TMPB}; pg8::gemm_phase(lds, A, B, 512, S, E); }
    }
    XCD_SYNC();

    {
        Op<0> A{(const char*)MIX, 256 * 2048, 2048, 128 * 2048}; Op<0> B{(const char*)WoT, 256 * 2048, 2048, 128 * 2048};
        StaticOrder S; S.init(384, 4, G, bx); pg8::EpiRes<true> E{xp, xs, out, XB, ssq2};
        pg8::gemm_phase(lds, A, B, 1024, S, E);
    }
    XCD_SYNC();

    {
        Op<3> A{(const char*)XB, 0, 2048, 128 * 2048}; Op<0> B{(const char*)WupT, 256 * 2048, 2048, 128 * 2048};
        StaticOrder S; S.init(402, 22, G, bx); pg8::EpiUp E{ssq2, conv_w, conv_b, ACT, (LAS float*)(lds + EX_OFF)};
        pg8::gemm_phase(lds, A, B, 1024, S, E);
    }
    XCD_SYNC();

    if (G == 256) {
    {
        Op<0> A{(const char*)ACT, (size_t)256 * DFF * 2, DFF * 2, (size_t)128 * DFF * 2}; Op<0> B{(const char*)WdT, (size_t)256 * DFF * 2, DFF * 2, (size_t)128 * DFF * 2};
        StaticOrder S; S.init(384, 4, G, bx); pg8::EpiFinal E{out, ssq3, (unsigned*)(ws + WS_PCNT), g_final};
        pg8::gemm_phase(lds, A, B, DFF, S, E);
    }
    } else {
    {
        Op<0> A{(const char*)ACT, (size_t)256 * DFF * 2, DFF * 2, (size_t)128 * DFF * 2}; Op<0> B{(const char*)WdT, (size_t)256 * DFF * 2, DFF * 2, (size_t)128 * DFF * 2};
        StaticOrder S; S.init(384, 4, G, bx); pg8::EpiRes<false> E{xp, xs, out, XB, ssq3};
        pg8::gemm_phase(lds, A, B, DFF, S, E);
    }
    XCD_SYNC();

    int tid8 = threadIdx.x; asm volatile("" : "+v"(tid8));
    const int lane = tid8 & 63, gw = vcu * NWAVES + __builtin_amdgcn_readfirstlane(tid8 >> 6);
    for (int row = gw; row < T; row += 2 * NGW) {
        const int row2 = row + NGW; const bool has2 = row2 < T; const int rb = has2 ? row2 : row;
        const float sc = __builtin_amdgcn_rsqf(ssq3[row] * (1.0f / 1024.0f) + EPS), sc2 = __builtin_amdgcn_rsqf(ssq3[rb] * (1.0f / 1024.0f) + EPS);
        f32x4* o = (f32x4*)(out + (size_t)row * 1024) + lane; f32x4* o2 = (f32x4*)(out + (size_t)rb * 1024) + lane;
        f32x4 v[4], w[4];
#pragma unroll
        for (int j = 0; j < 4; ++j) { v[j] = o[64 * j]; w[j] = o2[64 * j]; }
#pragma unroll
        for (int j = 0; j < 4; ++j) { const f32x4 g = ((const f32x4*)g_final)[lane + 64 * j]; o[64 * j] = v[j] * sc * g; if (has2) o2[64 * j] = w[j] * sc2 * g; }
    }
    }
}

extern "C" void kernel_launch(void* const* d_in, const int* in_sizes, int n_in, void* d_out, int out_size, void* d_ws, size_t ws_size, hipStream_t stream) {
    static int grid = 0;
    if (grid == 0) {
        if (n_in != 17 || out_size != T * DM || ws_size < WS_END) { fprintf(stderr, "kernel_launch: unexpected shapes (n_in %d out %d ws %zu)\n", n_in, out_size, ws_size); grid = -1; return; }
        int dev = 0, cus = 0, per_cu = 0;
        if (hipGetDevice(&dev) != hipSuccess || hipDeviceGetAttribute(&cus, hipDeviceAttributeMultiprocessorCount, dev) != hipSuccess) { grid = -1; return; }
        if (hipFuncSetAttribute((const void*)mega_fwd, hipFuncAttributeMaxDynamicSharedMemorySize, LDS_BYTES) != hipSuccess) { fprintf(stderr, "kernel_launch: hipFuncSetAttribute failed\n"); grid = -1; return; }
        if (hipOccupancyMaxActiveBlocksPerMultiprocessor(&per_cu, (const void*)mega_fwd, 512, LDS_BYTES) != hipSuccess || per_cu < 1) { fprintf(stderr, "kernel_launch: occupancy query says %d\n", per_cu); per_cu = 1; }
        (void)hipGetLastError();
        grid = cus * 1;
    }
    if (grid < 0) return;
    Args a{};
    for (int i = 0; i < 17; ++i) a.in[i] = (const float*)d_in[i];
    a.out = (float*)d_out; a.ws = (unsigned char*)d_ws;
    void* args[] = {&a};
    hipError_t e = hipLaunchCooperativeKernel((const void*)mega_fwd, dim3(grid), dim3(512), args, LDS_BYTES, stream);
    if (e != hipSuccess) fprintf(stderr, "kernel_launch: cooperative launch failed: %s (grid %d)\n", hipGetErrorString(e), grid);
}
```
